# Optimizing an MI355X kernel written in HIP

```python
import math
import jax
import jax.numpy as jnp
from jax import lax
import numpy as np

D_MODEL = 2048
BATCH = 8
SEQ = 2048
DEPTH = 2

N_A_LAYERS = DEPTH // 2
N_B_LAYERS = DEPTH - N_A_LAYERS

DEEPNORM_ALPHA = (2 * DEPTH) ** 0.25
DEEPNORM_BETA = (8 * DEPTH) ** -0.25
LN_EPS = 1e-5
MACARON_WEIGHT = 0.5

D_FF = ((8 * D_MODEL // 3 + 255) // 256) * 256

RET_HEADS = 8
RET_QK_DIM = D_MODEL // RET_HEADS
RET_V_DIM = 2 * D_MODEL // RET_HEADS
RET_CHUNK = 128
RET_ROPE_BASE = 10000.0

NSA_HEADS = 16
NSA_KV_GROUPS = 4
NSA_HEAD_DIM = D_MODEL // NSA_HEADS
NSA_HEADS_PER_GROUP = NSA_HEADS // NSA_KV_GROUPS
CMP_BLOCK = 32
CMP_STRIDE = 16
CMP_HIDDEN = 4 * NSA_HEAD_DIM
SLC_BLOCK = 64
SLC_TOP = 8
WINDOW = 512
NSA_QUERY_BLOCK = 64
FORCE_BONUS = 1e4

ROPE_THETA = 500000.0
ROPE_DIMS = NSA_HEAD_DIM // 4

NEG_INF = -1e30

kernel_name = "yoco_retention_nsa_macaron_deepnorm"


def layer_norm(x, g, b):
    xf = x.astype(jnp.float32)
    mu = jnp.mean(xf, axis=-1, keepdims=True)
    var = jnp.mean(jnp.square(xf - mu), axis=-1, keepdims=True)
    return ((xf - mu) * lax.rsqrt(var + LN_EPS) * g.astype(jnp.float32) + b.astype(jnp.float32)).astype(x.dtype)


def swiglu(x, w_in, w_out):
    a, u = jnp.split(x @ w_in, 2, axis=-1)
    return (jax.nn.silu(a) * u) @ w_out


def rotary(x, pos, rot_dims, theta):
    half = rot_dims // 2
    inv_freq = jnp.power(jnp.float32(theta), -jnp.arange(half, dtype=jnp.float32) / half)
    ang = pos.astype(jnp.float32)[:, None] * inv_freq[None, :]
    cos, sin = jnp.cos(ang), jnp.sin(ang)
    xf = x.astype(jnp.float32)
    x1, x2 = xf[..., :half], xf[..., half:rot_dims]
    out = jnp.concatenate([x1 * cos - x2 * sin, x2 * cos + x1 * sin, xf[..., rot_dims:]], axis=-1)
    return out.astype(x.dtype)


def retention(x, w_in, gn_g, gn_b, w_out):
    bsz, t_len, _ = x.shape
    h, dk, dv = RET_HEADS, RET_QK_DIM, RET_V_DIM
    proj = x @ w_in
    q, k, v, g = jnp.split(proj, [h * dk, 2 * h * dk, 2 * h * dk + h * dv], axis=-1)
    heads = lambda t, d: t.reshape(bsz, t_len, h, d).transpose(0, 2, 1, 3)
    pos = jnp.arange(t_len)
    q = rotary(heads(q, dk), pos, dk, RET_ROPE_BASE).astype(jnp.float32)
    k = rotary(heads(k, dk), pos, dk, RET_ROPE_BASE).astype(jnp.float32) * (dk ** -0.5)
    v = heads(v, dv).astype(jnp.float32)

    log_gamma = jnp.log(1.0 - jnp.power(2.0, -5.0 - jnp.arange(h, dtype=jnp.float32)))
    c = RET_CHUNK
    n_chunks = t_len // c
    idx = jnp.arange(c, dtype=jnp.float32)
    diff = idx[:, None] - idx[None, :]
    decay_inner = jnp.where(diff >= 0, jnp.exp(log_gamma[:, None, None] * jnp.maximum(diff, 0.0)), 0.0)
    xi = jnp.exp(log_gamma[:, None] * (idx + 1.0))[..., None]
    zeta = jnp.exp(log_gamma[:, None] * (c - 1.0 - idx))[..., None]
    gamma_c = jnp.exp(log_gamma * c)[:, None, None]

    chunk = lambda t: t.reshape(bsz, h, n_chunks, c, t.shape[-1]).transpose(2, 0, 1, 3, 4)

    def step(state, inp):
        qi, ki, vi = inp
        s = jnp.einsum('bhnd,bhmd->bhnm', qi, ki) * decay_inner
        inner = jnp.einsum('bhnm,bhmv->bhnv', s, vi)
        cross = jnp.einsum('bhnd,bhdv->bhnv', qi, state) * xi
        new_state = jnp.einsum('bhmd,bhmv->bhdv', ki * zeta, vi) + gamma_c * state
        return new_state, inner + cross

    state0 = jnp.zeros((bsz, h, dk, dv), jnp.float32)
    _, out = lax.scan(step, state0, (chunk(q), chunk(k), chunk(v)))
    out = out.transpose(1, 0, 3, 2, 4).reshape(bsz, t_len, h, dv)
    mu = jnp.mean(out, axis=-1, keepdims=True)
    var = jnp.mean(jnp.square(out - mu), axis=-1, keepdims=True)
    gn = (out - mu) * lax.rsqrt(var + LN_EPS)
    gn = gn.reshape(bsz, t_len, h * dv) * gn_g.astype(jnp.float32) + gn_b.astype(jnp.float32)
    y = jax.nn.silu(g.astype(jnp.float32)) * gn
    return y.astype(x.dtype) @ w_out


def nsa_shared_kv(h, kv_w, cmp_pos, cmp_w1, cmp_b1, cmp_w2):
    bsz, t_len, _ = h.shape
    g, hd = NSA_KV_GROUPS, NSA_HEAD_DIM
    kv = (h @ kv_w).reshape(bsz, t_len, 6, g, hd).transpose(2, 0, 3, 1, 4)
    n_cmp = (t_len - CMP_BLOCK) // CMP_STRIDE + 1
    blk = jnp.arange(n_cmp)[:, None] * CMP_STRIDE + jnp.arange(CMP_BLOCK)[None, :]
    blocks = kv[0:2][:, :, :, blk, :] + cmp_pos[:, None, None, None]
    flat = blocks.reshape(2, bsz, g, n_cmp, CMP_BLOCK * hd)
    hid = jax.nn.gelu(jnp.einsum('cbgnf,cfe->cbgne', flat, cmp_w1) + cmp_b1[:, None, None, None])
    comp = jnp.einsum('cbgne,ced->cbgnd', hid, cmp_w2)
    pos = jnp.arange(t_len)
    cmp_end = jnp.arange(n_cmp) * CMP_STRIDE + CMP_BLOCK - 1
    k_cmp = rotary(comp[0], cmp_end, ROPE_DIMS, ROPE_THETA)
    v_cmp = comp[1]
    k_slc = rotary(kv[2], pos, ROPE_DIMS, ROPE_THETA)
    k_win = rotary(kv[4], pos, ROPE_DIMS, ROPE_THETA)
    return (k_cmp, v_cmp, k_slc, kv[3], k_win, kv[5])


def overlap_matrix(t_len):
    n_cmp = (t_len - CMP_BLOCK) // CMP_STRIDE + 1
    n_slc = t_len // SLC_BLOCK
    cs = np.arange(n_cmp)[:, None] * CMP_STRIDE
    ss = np.arange(n_slc)[None, :] * SLC_BLOCK
    return jnp.asarray(((cs < ss + SLC_BLOCK) & (cs + CMP_BLOCK > ss)).astype(np.float32))


def nsa_attention(x, kvs, w_in, w_out):
    k_cmp, v_cmp, k_slc, v_slc, k_win, v_win = kvs
    bsz, t_len, _ = x.shape
    h, g, hg, hd = NSA_HEADS, NSA_KV_GROUPS, NSA_HEADS_PER_GROUP, NSA_HEAD_DIM
    proj = x @ w_in
    q = proj[..., :h * hd].reshape(bsz, t_len, g, hg, hd).transpose(0, 2, 3, 1, 4)
    gates = jax.nn.sigmoid(proj[..., h * hd:].astype(jnp.float32)).reshape(bsz, t_len, g, hg, 3).transpose(0, 2, 3, 1, 4)
    pos = jnp.arange(t_len)
    q = rotary(q, pos, ROPE_DIMS, ROPE_THETA) * (hd ** -0.5)

    n_cmp = k_cmp.shape[2]
    cmp_end = jnp.arange(n_cmp) * CMP_STRIDE + CMP_BLOCK - 1
    cmp_mask = cmp_end[None, :] <= pos[:, None]
    has_cmp = jnp.any(cmp_mask, axis=-1).astype(jnp.float32)[:, None]
    s_cmp = jnp.einsum('bgitd,bgnd->bgitn', q, k_cmp).astype(jnp.float32)
    p_cmp = jax.nn.softmax(jnp.where(cmp_mask, s_cmp, NEG_INF), axis=-1) * has_cmp
    o_cmp = jnp.einsum('bgitn,bgnd->bgitd', p_cmp.astype(v_cmp.dtype), v_cmp)

    n_slc = t_len // SLC_BLOCK
    top = min(SLC_TOP, n_slc)
    p_slc = jnp.einsum('bgitn,nj->bgtj', p_cmp, overlap_matrix(t_len))
    blk_ids = jnp.arange(n_slc)
    cur = pos // SLC_BLOCK
    valid = (blk_ids * SLC_BLOCK)[None, :] <= pos[:, None]
    forced = (blk_ids[None, :] == 0) | (blk_ids[None, :] == cur[:, None]) | (blk_ids[None, :] == cur[:, None] - 1)
    score = jnp.where(valid, p_slc + jnp.where(forced, FORCE_BONUS, 0.0), -1.0)
    _, sel_idx = lax.top_k(score, top)

    k_slc_blk = k_slc.reshape(bsz, g, n_slc, SLC_BLOCK, hd)
    v_slc_blk = v_slc.reshape(bsz, g, n_slc, SLC_BLOCK, hd)
    pad = ((0, 0), (0, 0), (WINDOW, 0), (0, 0))
    k_win_pad = jnp.pad(k_win, pad)
    v_win_pad = jnp.pad(v_win, pad)
    qb_len = NSA_QUERY_BLOCK
    n_qb = t_len // qb_len
    gather = jax.vmap(jax.vmap(lambda kb, ib: kb[ib]))

    def block_fn(qb):
        s0 = qb * qb_len
        q_b = lax.dynamic_slice_in_dim(q, s0, qb_len, axis=3)
        t_b = s0 + jnp.arange(qb_len)
        idx_b = lax.dynamic_slice_in_dim(sel_idx, s0, qb_len, axis=2)
        kg = gather(k_slc_blk, idx_b).reshape(bsz, g, qb_len, top * SLC_BLOCK, hd)
        vg = gather(v_slc_blk, idx_b).reshape(bsz, g, qb_len, top * SLC_BLOCK, hd)
        tok = (idx_b[..., None] * SLC_BLOCK + jnp.arange(SLC_BLOCK)).reshape(bsz, g, qb_len, top * SLC_BLOCK)
        m_slc = tok <= t_b[:, None]
        s = jnp.einsum('bgiqd,bgqkd->bgiqk', q_b, kg).astype(jnp.float32)
        p = jax.nn.softmax(jnp.where(m_slc[:, :, None], s, NEG_INF), axis=-1)
        o_s = jnp.einsum('bgiqk,bgqkd->bgiqd', p.astype(vg.dtype), vg)
        kw = lax.dynamic_slice_in_dim(k_win_pad, s0, WINDOW + qb_len, axis=2)
        vw = lax.dynamic_slice_in_dim(v_win_pad, s0, WINDOW + qb_len, axis=2)
        kpos = s0 - WINDOW + jnp.arange(WINDOW + qb_len)
        m_win = (kpos[None, :] >= 0) & (kpos[None, :] <= t_b[:, None]) & (kpos[None, :] > t_b[:, None] - WINDOW)
        sw = jnp.einsum('bgiqd,bgkd->bgiqk', q_b, kw).astype(jnp.float32)
        pw = jax.nn.softmax(jnp.where(m_win, sw, NEG_INF), axis=-1)
        o_w = jnp.einsum('bgiqk,bgkd->bgiqd', pw.astype(vw.dtype), vw)
        return o_s, o_w

    o_slc, o_win = lax.map(block_fn, jnp.arange(n_qb))
    o_slc = jnp.moveaxis(o_slc, 0, 3).reshape(bsz, g, hg, t_len, hd)
    o_win = jnp.moveaxis(o_win, 0, 3).reshape(bsz, g, hg, t_len, hd)

    o = gates[..., 0:1] * o_cmp + gates[..., 1:2] * o_slc + gates[..., 2:3] * o_win
    o = o.astype(x.dtype).transpose(0, 3, 1, 2, 4).reshape(bsz, t_len, h * hd)
    return o @ w_out


def setup_inputs(seed: int = 0) -> dict:
    key = jax.random.key(seed)
    ks = jax.random.split(key, 24)
    f32 = jnp.float32

    def w(k, shape, fan_in, scale=1.0):
        return jax.random.normal(k, shape, f32) * (scale * fan_in ** -0.5)

    ret_cols = 2 * RET_HEADS * RET_QK_DIM + 2 * RET_HEADS * RET_V_DIM
    nsa_cols = NSA_HEADS * NSA_HEAD_DIM + 3 * NSA_HEADS
    return {
        "x": jax.random.normal(ks[0], (BATCH, SEQ, D_MODEL), f32),
        "ln_g": 1.0 + 0.02 * jax.random.normal(ks[1], (DEPTH, 3, D_MODEL), f32),
        "ln_b": 0.02 * jax.random.normal(ks[2], (DEPTH, 3, D_MODEL), f32),
        "ffn1_w_in": w(ks[3], (DEPTH, D_MODEL, 2 * D_FF), D_MODEL),
        "ffn1_w_out": w(ks[4], (DEPTH, D_FF, D_MODEL), D_FF, DEEPNORM_BETA),
        "ffn2_w_in": w(ks[5], (DEPTH, D_MODEL, 2 * D_FF), D_MODEL),
        "ffn2_w_out": w(ks[6], (DEPTH, D_FF, D_MODEL), D_FF, DEEPNORM_BETA),
        "ret_w_in": w(ks[7], (N_A_LAYERS, D_MODEL, ret_cols), D_MODEL),
        "ret_gn_g": 1.0 + 0.02 * jax.random.normal(ks[8], (N_A_LAYERS, RET_HEADS * RET_V_DIM), f32),
        "ret_gn_b": 0.02 * jax.random.normal(ks[9], (N_A_LAYERS, RET_HEADS * RET_V_DIM), f32),
        "ret_w_out": w(ks[10], (N_A_LAYERS, RET_HEADS * RET_V_DIM, D_MODEL), RET_HEADS * RET_V_DIM, DEEPNORM_BETA),
        "kv_w": w(ks[11], (D_MODEL, 6 * NSA_KV_GROUPS * NSA_HEAD_DIM), D_MODEL),
        "cmp_pos": 0.1 * jax.random.normal(ks[12], (2, CMP_BLOCK, NSA_HEAD_DIM), f32),
        "cmp_w1": w(ks[13], (2, CMP_BLOCK * NSA_HEAD_DIM, CMP_HIDDEN), CMP_BLOCK * NSA_HEAD_DIM),
        "cmp_b1": 0.02 * jax.random.normal(ks[14], (2, CMP_HIDDEN), f32),
        "cmp_w2": w(ks[15], (2, CMP_HIDDEN, NSA_HEAD_DIM), CMP_HIDDEN),
        "nsa_w_q": w(ks[16], (N_B_LAYERS, D_MODEL, nsa_cols), D_MODEL),
        "nsa_w_out": w(ks[17], (N_B_LAYERS, NSA_HEADS * NSA_HEAD_DIM, D_MODEL), NSA_HEADS * NSA_HEAD_DIM, DEEPNORM_BETA),
    }


def reference(x, ln_g, ln_b, ffn1_w_in, ffn1_w_out, ffn2_w_in, ffn2_w_out, ret_w_in, ret_gn_g, ret_gn_b, ret_w_out, kv_w, cmp_pos, cmp_w1, cmp_b1, cmp_w2, nsa_w_q, nsa_w_out):
    kvs = None
    for layer in range(DEPTH):
        x = layer_norm(DEEPNORM_ALPHA * x + MACARON_WEIGHT * swiglu(x, ffn1_w_in[layer], ffn1_w_out[layer]), ln_g[layer, 0], ln_b[layer, 0])
        if layer < N_A_LAYERS:
            mix = retention(x, ret_w_in[layer], ret_gn_g[layer], ret_gn_b[layer], ret_w_out[layer])
        else:
            j = layer - N_A_LAYERS
            mix = nsa_attention(x, kvs, nsa_w_q[j], nsa_w_out[j])
        x = layer_norm(DEEPNORM_ALPHA * x + mix, ln_g[layer, 1], ln_b[layer, 1])
        x = layer_norm(DEEPNORM_ALPHA * x + MACARON_WEIGHT * swiglu(x, ffn2_w_in[layer], ffn2_w_out[layer]), ln_g[layer, 2], ln_b[layer, 2])
        if layer == N_A_LAYERS - 1:
            kvs = nsa_shared_kv(x, kv_w, cmp_pos, cmp_w1, cmp_b1, cmp_w2)
    return x
```

```cpp
#include <hip/hip_runtime.h>
#include <hip/hip_cooperative_groups.h>
#include <cstdint>
#include <cstdio>
namespace cg = cooperative_groups;

#define LAS __attribute__((address_space(3)))
typedef unsigned short bf16_t;
typedef short bf16x8 __attribute__((ext_vector_type(8)));
typedef short s16x4 __attribute__((ext_vector_type(4)));
typedef float f32x4 __attribute__((ext_vector_type(4)));
typedef float f32x16 __attribute__((ext_vector_type(16)));
typedef unsigned u32x4 __attribute__((ext_vector_type(4)));
typedef unsigned u32x2 __attribute__((ext_vector_type(2)));
typedef LAS unsigned char* ldsp;

constexpr int BATCH = 8, T = 2048, D = 2048, M = BATCH * T, FF = 5632;
constexpr int RETC = 12288;
constexpr int KVC = 3072, NQC = 2304;
constexpr float ALPHA = 1.41421356237f, LN_EPS = 1e-5f;
constexpr float QSCALE = 0.08838834764831845f * 1.4426950408889634f;
constexpr int RC = 64;

constexpr size_t MiB = 1u << 20;
constexpr size_t W_FFN1_IN = 0;
constexpr size_t W_FFN1_OUT = W_FFN1_IN + (size_t)2 * FF * D * 2;
constexpr size_t W_FFN2_IN = W_FFN1_OUT + (size_t)D * FF * 2;
constexpr size_t W_FFN2_OUT = W_FFN2_IN + (size_t)2 * FF * D * 2;
constexpr size_t W_X0 = W_FFN2_OUT + (size_t)D * FF * 2;
constexpr size_t W_RET_IN = W_X0;
constexpr size_t W_RET_OUT = W_RET_IN + (size_t)RETC * D * 2;
constexpr size_t W_KV = W_RET_OUT + (size_t)D * 4096 * 2;
constexpr size_t W_CMP1 = W_KV + (size_t)KVC * D * 2;
constexpr size_t W_END0 = W_CMP1 + (size_t)1024 * 4096 * 2;
constexpr size_t W_NSA_Q = W_X0;
constexpr size_t W_NSA_OUT = W_NSA_Q + (size_t)NQC * D * 2;
constexpr size_t WS_XB = 216 * MiB;
constexpr size_t WS_KV = 280 * MiB;
constexpr size_t WS_R = 376 * MiB;
constexpr size_t WS_KC = 760 * MiB, WS_VC = 761 * MiB;
constexpr size_t WS_ROPE_R = 762 * MiB;
constexpr size_t WS_ROPE_N = 764 * MiB;
static_assert(W_END0 <= WS_XB, "weights region");
constexpr size_t R_H = 0;
constexpr size_t R_ACMP = 0;
constexpr size_t R_HC = 64 * MiB;
constexpr size_t R_QN = 0;
constexpr size_t R_O = 72 * MiB;

constexpr int LDS_BYTES = 135168;

__device__ __forceinline__ int opaque_tid() { int t = threadIdx.x; asm volatile("" : "+v"(t)); return t; }
__device__ __forceinline__ int rfl(int v) { return __builtin_amdgcn_readfirstlane(v); }
__device__ __forceinline__ unsigned f2bf(float f) { unsigned u = __builtin_bit_cast(unsigned, f); return (u + 0x7fffu + ((u >> 16) & 1u)) >> 16; }
__device__ __forceinline__ unsigned pk2(float lo, float hi) { unsigned r; asm volatile("v_cvt_pk_bf16_f32 %0, %1, %2" : "=v"(r) : "v"(lo), "v"(hi)); return r; }
__device__ __forceinline__ float bf2f(unsigned short b) { return __builtin_bit_cast(float, (unsigned)b << 16); }
__device__ __forceinline__ float bflo(unsigned w) { return __builtin_bit_cast(float, w << 16); }
__device__ __forceinline__ float bfhi(unsigned w) { return __builtin_bit_cast(float, w & 0xffff0000u); }
__device__ __forceinline__ float ex2(float x) { return __builtin_amdgcn_exp2f(x); }
__device__ __forceinline__ float siluf(float a) { return a * __builtin_amdgcn_rcpf(1.f + ex2(-1.4426950408889634f * a)); }
__device__ __forceinline__ float sigmf(float a) { return __builtin_amdgcn_rcpf(1.f + ex2(-1.4426950408889634f * a)); }
__device__ __forceinline__ float gelu_tanh(float x) {
    const float u = 0.7978845608028654f * (x + 0.044715f * x * x * x);
    const float e = ex2(2.8853900817779268f * u);
    const float th = 1.f - 2.f * __builtin_amdgcn_rcpf(e + 1.f);
    return 0.5f * x * (1.f + th);
}
__device__ __forceinline__ float wave_sum(float v) {
#pragma unroll
    for (int o = 1; o < 64; o <<= 1) v += __shfl_xor(v, o);
    return v;
}
__device__ __forceinline__ f32x4 mfma16(bf16x8 a, bf16x8 b, f32x4 c) { return __builtin_amdgcn_mfma_f32_16x16x32_bf16(a, b, c, 0, 0, 0); }
__device__ __forceinline__ f32x16 mfma32(bf16x8 a, bf16x8 b, f32x16 c) { return __builtin_amdgcn_mfma_f32_32x32x16_bf16(a, b, c, 0, 0, 0); }
typedef short v4i16_t __attribute__((ext_vector_type(4)));
__device__ __forceinline__ s16x4 trrd(ldsp p) { return __builtin_bit_cast(s16x4, __builtin_amdgcn_ds_read_tr16_b64_v4i16((LAS v4i16_t*)p)); }
__device__ __forceinline__ bf16x8 cat8(s16x4 lo, s16x4 hi) { return (bf16x8){lo[0], lo[1], lo[2], lo[3], hi[0], hi[1], hi[2], hi[3]}; }
__device__ __forceinline__ int vcu_of() { const int G = gridDim.x, bx = blockIdx.x; return (G % 8 == 0) ? (bx % 8) * (G / 8) + bx / 8 : bx; }

namespace pg8 {
constexpr int BM = 256, BK = 64, HALF = 128, HTB = HALF * BK * 2, STAGE_BYTES = 8 * HTB, NXCD = 8, WGM = 8;
__host__ __device__ __forceinline__ int lds_byte(int r, int c) { const int st = (r >> 4) * 2 + (c >> 5), rr = r & 15, cc = c & 31, ob = rr * 64 + cc * 2; return st * 1024 + (ob ^ (((ob >> 9) & 1) << 5)); }
__host__ __device__ __forceinline__ void stage_rc(int b, int& R, int& C) { const int st = b / 1024, sb = b % 1024, swz = sb ^ (((sb >> 9) & 1) << 5); R = (st >> 1) * 16 + swz / 64; C = (st & 1) * 32 + (swz % 64) / 2; }
__host__ __device__ __forceinline__ int perm32(int rho) { const int n = rho >> 4, i = rho & 15; return 8 * (i >> 2) + 4 * n + (i & 3); }
struct Unit { int pm, pn; };
struct Gemm { const bf16_t* A; const bf16_t* Bt; int M, N, K, lda; };
struct StaticOrder {
    int nM, nN, nwg, G, c;
    __device__ void init(int M_, int N_, int G_, int c_) { nM = M_ / BM; nN = N_ / BM; nwg = nM * nN; G = G_; c = c_; }
    __device__ bool next(int i, Unit& u) const {
        const long L = (long)i * G + c; if (L >= nwg) return false;
        int wgid = (int)L; { const int q = nwg / NXCD, r = nwg % NXCD, xcd = wgid % NXCD, off = wgid / NXCD; wgid = (xcd < r ? xcd * (q + 1) : r * (q + 1) + (xcd - r) * q) + off; }
        const int nig = WGM * nN, gid = wgid / nig, fm = gid * WGM, gsz = (nM - fm) < WGM ? (nM - fm) : WGM;
        u.pm = fm + ((wgid % nig) % gsz); u.pn = (wgid % nig) / gsz; return true;
    }
};
struct CmpOrder {
    int G, c;
    __device__ bool next(int i, Unit& u) const { const int L = i * G + c; if (L >= 64) return false; const int cc = L >> 5, r = L & 31; u.pm = cc * 16 + (r >> 1); u.pn = cc * 2 + (r & 1); return true; }
};

enum { EPI_SWIGLU = 0, EPI_RESID = 1, EPI_RET = 2, EPI_KV = 3, EPI_NSAQ = 4, EPI_CMP1 = 5 };
template <int MODE> struct Epi {
    static constexpr bool PERM = (MODE == EPI_SWIGLU || MODE == EPI_RET || MODE == EPI_CMP1);
    void* out; const float* src; int ldc; float alpha, beta; const float* tcos; const float* tsin;
    __device__ __forceinline__ void operator()(const f32x4 (&acc)[2][2][4][2], const Unit& u, int wr, int wc, int fr, int fq) const {
        if constexpr (MODE == EPI_SWIGLU) {
            bf16_t* O = (bf16_t*)out; const int col0 = u.pn * 128 + wc * 32 + 8 * fq;
#pragma unroll
            for (int ai = 0; ai < 2; ++ai)
#pragma unroll
                for (int m = 0; m < 4; ++m) {
                    const int row = u.pm * BM + ai * HALF + wr * 64 + m * 16 + fr;
                    const f32x4 a0 = acc[ai][0][m][0], a1 = acc[ai][0][m][1], u0 = acc[ai][1][m][0], u1 = acc[ai][1][m][1];
                    u32x4 w; w.x = pk2(siluf(a0[0]) * u0[0], siluf(a0[1]) * u0[1]); w.y = pk2(siluf(a0[2]) * u0[2], siluf(a0[3]) * u0[3]);
                    w.z = pk2(siluf(a1[0]) * u1[0], siluf(a1[1]) * u1[1]); w.w = pk2(siluf(a1[2]) * u1[2], siluf(a1[3]) * u1[3]);
                    *(u32x4*)(O + (size_t)row * ldc + col0) = w;
                }
        } else if constexpr (MODE == EPI_RESID) {
            float* Y = (float*)out; const int col0 = u.pn * BM + wc * 32 + 4 * fq;
#pragma unroll
            for (int ai = 0; ai < 2; ++ai)
#pragma unroll
                for (int m = 0; m < 4; ++m) {
                    const int row = u.pm * BM + ai * HALF + wr * 64 + m * 16 + fr; const size_t off = (size_t)row * ldc + col0;
#pragma unroll
                    for (int bj = 0; bj < 2; ++bj)
#pragma unroll
                        for (int n = 0; n < 2; ++n) { const f32x4 x = *(const f32x4*)(src + off + bj * HALF + n * 16); *(f32x4*)(Y + off + bj * HALF + n * 16) = x * alpha + acc[ai][bj][m][n] * beta; }
                    asm volatile("" ::: "memory");
                }
        } else if constexpr (MODE == EPI_RET) {
            bf16_t* O = (bf16_t*)out; const int colw = wc * 32 + 8 * fq;
            if (u.pn < 16) {
                const bool isk = u.pn >= 8; const int hh = u.pn & 7; const float l2g = __builtin_log2f(1.f - ex2(-5.f - (float)hh));
#pragma unroll
                for (int ai = 0; ai < 2; ++ai)
#pragma unroll
                    for (int m = 0; m < 4; ++m) {
                        const int row = u.pm * BM + ai * HALF + wr * 64 + m * 16 + fr, pos = row & (T - 1);
                        const float sc = isk ? 0.0625f * ex2(l2g * (float)(RC - 1 - (pos & (RC - 1)))) : 1.f;
                        f32x4 o1[2], o2[2];
#pragma unroll
                        for (int n = 0; n < 2; ++n) { const f32x4 cs = *(const f32x4*)(tcos + pos * 128 + colw + 4 * n), sn = *(const f32x4*)(tsin + pos * 128 + colw + 4 * n);
                            const f32x4 x1 = acc[ai][0][m][n], x2 = acc[ai][1][m][n]; o1[n] = (x1 * cs - x2 * sn) * sc; o2[n] = (x2 * cs + x1 * sn) * sc; }
                        bf16_t* rp = O + (size_t)row * ldc + u.pn * BM + colw;
                        u32x4 w; w.x = pk2(o1[0][0], o1[0][1]); w.y = pk2(o1[0][2], o1[0][3]); w.z = pk2(o1[1][0], o1[1][1]); w.w = pk2(o1[1][2], o1[1][3]); *(u32x4*)rp = w;
                        w.x = pk2(o2[0][0], o2[0][1]); w.y = pk2(o2[0][2], o2[0][3]); w.z = pk2(o2[1][0], o2[1][1]); w.w = pk2(o2[1][2], o2[1][3]); *(u32x4*)(rp + HALF) = w;
                        asm volatile("" ::: "memory");
                    }
            } else {
#pragma unroll
                for (int ai = 0; ai < 2; ++ai)
#pragma unroll
                    for (int m = 0; m < 4; ++m) {
                        const int row = u.pm * BM + ai * HALF + wr * 64 + m * 16 + fr; bf16_t* rp = O + (size_t)row * ldc + u.pn * BM + colw;
#pragma unroll
                        for (int bj = 0; bj < 2; ++bj) { const f32x4 v0 = acc[ai][bj][m][0], v1 = acc[ai][bj][m][1]; u32x4 w; w.x = pk2(v0[0], v0[1]); w.y = pk2(v0[2], v0[3]); w.z = pk2(v1[0], v1[1]); w.w = pk2(v1[2], v1[3]); *(u32x4*)(rp + bj * HALF) = w; }
                    }
            }
        } else if constexpr (MODE == EPI_KV || MODE == EPI_NSAQ) {
            bf16_t* O = (bf16_t*)out;
            bool rope; float sc = 1.f;
            if constexpr (MODE == EPI_KV) { const int cidx = u.pn >> 1; rope = (cidx == 2 || cidx == 4) && wc == 0; }
            else { rope = (u.pn < 8) && wc == 0; sc = (u.pn < 8) ? alpha : 1.f; }
#pragma unroll
            for (int ai = 0; ai < 2; ++ai)
#pragma unroll
                for (int m = 0; m < 4; ++m) {
                    const int row = u.pm * BM + ai * HALF + wr * 64 + m * 16 + fr, pos = row & (T - 1);
                    f32x4 cs = (f32x4){1.f, 1.f, 1.f, 1.f}, sn = (f32x4){0.f, 0.f, 0.f, 0.f};
                    if (rope) { cs = *(const f32x4*)(tcos + pos * 16 + 4 * fq); sn = *(const f32x4*)(tsin + pos * 16 + 4 * fq); }
                    bf16_t* rp = O + (size_t)row * ldc + u.pn * BM + wc * 32 + 4 * fq;
#pragma unroll
                    for (int bj = 0; bj < 2; ++bj) { const f32x4 x1 = acc[ai][bj][m][0], x2 = acc[ai][bj][m][1];
                        const f32x4 o1 = (x1 * cs - x2 * sn) * sc, o2 = (x2 * cs + x1 * sn) * sc;
                        u32x2 w; w.x = pk2(o1[0], o1[1]); w.y = pk2(o1[2], o1[3]); *(u32x2*)(rp + bj * HALF) = w;
                        w.x = pk2(o2[0], o2[1]); w.y = pk2(o2[2], o2[3]); *(u32x2*)(rp + bj * HALF + 16) = w; }
                    asm volatile("" ::: "memory");
                }
        } else {
            bf16_t* O = (bf16_t*)out; const int colw = wc * 32 + 8 * fq;
#pragma unroll
            for (int ai = 0; ai < 2; ++ai)
#pragma unroll
                for (int m = 0; m < 4; ++m) {
                    const int row = u.pm * BM + ai * HALF + wr * 64 + m * 16 + fr; bf16_t* rp = O + (size_t)row * ldc + (u.pn & 1) * BM + colw;
#pragma unroll
                    for (int bj = 0; bj < 2; ++bj) { const float* bp = src + u.pn * BM + bj * HALF + colw; const f32x4 b0 = *(const f32x4*)bp, b1 = *(const f32x4*)(bp + 4);
                        const f32x4 v0 = acc[ai][bj][m][0] + b0, v1 = acc[ai][bj][m][1] + b1; u32x4 w;
                        w.x = pk2(gelu_tanh(v0[0]), gelu_tanh(v0[1])); w.y = pk2(gelu_tanh(v0[2]), gelu_tanh(v0[3])); w.z = pk2(gelu_tanh(v1[0]), gelu_tanh(v1[1])); w.w = pk2(gelu_tanh(v1[2]), gelu_tanh(v1[3]));
                        *(u32x4*)(rp + bj * HALF) = w; }
                    asm volatile("" ::: "memory");
                }
        }
    }
};

template <class Epi, class Sched>
__device__ __forceinline__ void gemm_phase(ldsp lds, const Gemm g, const Sched& S, const Epi& E) {
    const int tid = opaque_tid(), wid = __builtin_amdgcn_readfirstlane(tid >> 6), lane = tid & 63, wr = wid >> 2, wc = wid & 3, fr = lane & 15, fq = lane >> 4;
    const int K = g.K, nt = K / BK, lda = g.lda;
    unsigned voffA[2], voffB[2];
#pragma unroll
    for (int i = 0; i < 2; ++i) { int R, C; stage_rc(tid * 16 + i * 8192, R, C); const int Rb = Epi::PERM ? ((R & ~31) + perm32(R & 31)) : R;
        voffA[i] = (unsigned)(R * lda + C) * 2u; voffB[i] = (unsigned)(Rb * K + C) * 2u; }
    const size_t kstep = (size_t)(BK * 2);
    const size_t hstepA = (size_t)HALF * lda * 2, hstepB = (size_t)HALF * K * 2;
    const size_t tstepA = 2 * hstepA, tstepB = 2 * hstepB;
    const unsigned ldsw = (unsigned)wid * 1024u;
    const int aoff = lds_byte(wr * 64 + fr, fq * 8), boff = lds_byte(wc * 32 + fr, fq * 8);
#define PG8_SA(b, h) (((b) * 2 + (h)) * HTB)
#define PG8_SB(b, h) ((4 + (b) * 2 + (h)) * HTB)
#define PG8_STAGE(bufoff, gbase, voff) do { _Pragma("unroll") for (int _i = 0; _i < 2; ++_i) \
        __builtin_amdgcn_global_load_lds((const unsigned*)((const char*)(gbase) + (voff)[_i]), (LAS unsigned*)(lds + (bufoff) + ldsw + _i * 8192), 16, 0, 0); } while (0)
#define PG8_LDA(dst, b, h) do { _Pragma("unroll") for (int m = 0; m < 4; ++m) _Pragma("unroll") for (int k = 0; k < 2; ++k) dst[m][k] = *(const LAS bf16x8*)(lds + PG8_SA(b, h) + aoff + m * 2048 + k * 1024); } while (0)
#define PG8_LDB(dst, b, h) do { _Pragma("unroll") for (int n = 0; n < 2; ++n) _Pragma("unroll") for (int k = 0; k < 2; ++k) dst[n][k] = *(const LAS bf16x8*)(lds + PG8_SB(b, h) + boff + n * 2048 + k * 1024); } while (0)
#define PG8_MMA(ai, bj, At, Bt) do { __builtin_amdgcn_s_setprio(1); _Pragma("unroll") for (int m = 0; m < 4; ++m) _Pragma("unroll") for (int n = 0; n < 2; ++n) _Pragma("unroll") for (int k = 0; k < 2; ++k) \
        acc[ai][bj][m][n] = __builtin_amdgcn_mfma_f32_16x16x32_bf16(Bt[n][k], At[m][k], acc[ai][bj][m][n], 0, 0, 0); __builtin_amdgcn_s_setprio(0); } while (0)
#define PG8_WAIT_V(n) asm volatile("s_waitcnt vmcnt(" #n ")" ::: "memory")
#define PG8_WAIT_L(n) asm volatile("s_waitcnt lgkmcnt(" #n ")" ::: "memory")
#define PG8_BAR __builtin_amdgcn_s_barrier()
#define PG8_SCHED __builtin_amdgcn_sched_barrier(0)
    Unit cur, nxt; int ui = 0;
    if (!S.next(0, cur)) return;
    f32x4 acc[2][2][4][2];
#pragma unroll
    for (int a = 0; a < 2; ++a)
#pragma unroll
        for (int b = 0; b < 2; ++b)
#pragma unroll
            for (int m = 0; m < 4; ++m)
#pragma unroll
                for (int n = 0; n < 2; ++n) acc[a][b][m][n] = (f32x4){0.f, 0.f, 0.f, 0.f};
    bf16x8 At[4][2], B0[2][2], B1[2][2];
    const char* cA = (const char*)g.A + (size_t)cur.pm * tstepA; const char* cB = (const char*)g.Bt + (size_t)cur.pn * tstepB;
    PG8_STAGE(PG8_SB(0, 0), cB, voffB); PG8_STAGE(PG8_SB(0, 1), cB + hstepB, voffB); PG8_STAGE(PG8_SA(0, 0), cA, voffA); PG8_STAGE(PG8_SA(0, 1), cA + hstepA, voffA);
    if (wr == 1) PG8_BAR;
    PG8_WAIT_V(2); PG8_BAR;
    PG8_STAGE(PG8_SB(1, 0), cB + kstep, voffB); PG8_STAGE(PG8_SA(1, 0), cA + kstep, voffA); PG8_STAGE(PG8_SB(1, 1), cB + hstepB + kstep, voffB);
    PG8_WAIT_V(6); PG8_BAR;
    for (;;) {
        const bool has_next = S.next(ui + 1, nxt);
        const char* nA = has_next ? (const char*)g.A + (size_t)nxt.pm * tstepA : cA; const char* nB = has_next ? (const char*)g.Bt + (size_t)nxt.pn * tstepB : cB;
        for (int t = 0; t < nt; t += 2) {
            const bool last = (t == nt - 2);
            const char* a1 = cA + (size_t)(t + 1) * kstep;
            const char* a2 = last ? nA : cA + (size_t)(t + 2) * kstep; const char* b2 = last ? nB : cB + (size_t)(t + 2) * kstep;
            const char* a3 = a2 + kstep; const char* b3 = b2 + kstep;
            PG8_LDB(B0, 0, 0); PG8_LDB(B1, 0, 1); PG8_SCHED; PG8_LDA(At, 0, 0); PG8_STAGE(PG8_SA(1, 1), a1 + hstepA, voffA);
            PG8_WAIT_V(8); PG8_WAIT_L(0); PG8_BAR; PG8_MMA(0, 0, At, B0); PG8_MMA(0, 1, At, B1); PG8_BAR; PG8_SCHED;
            PG8_LDA(At, 0, 1); PG8_STAGE(PG8_SB(0, 0), b2, voffB); PG8_STAGE(PG8_SB(0, 1), b2 + hstepB, voffB); PG8_STAGE(PG8_SA(0, 0), a2, voffA);
            PG8_WAIT_V(8); PG8_WAIT_L(0); PG8_BAR; PG8_MMA(1, 0, At, B0); PG8_MMA(1, 1, At, B1); PG8_BAR; PG8_SCHED;
            PG8_LDB(B0, 1, 0); PG8_LDB(B1, 1, 1); PG8_SCHED; PG8_LDA(At, 1, 0); PG8_STAGE(PG8_SA(0, 1), a2 + hstepA, voffA);
            PG8_WAIT_V(8); PG8_WAIT_L(0); PG8_BAR; PG8_MMA(0, 0, At, B0); PG8_MMA(0, 1, At, B1); PG8_BAR; PG8_SCHED;
            PG8_LDA(At, 1, 1); PG8_STAGE(PG8_SB(1, 0), b3, voffB); PG8_STAGE(PG8_SB(1, 1), b3 + hstepB, voffB); PG8_STAGE(PG8_SA(1, 0), a3, voffA);
            PG8_WAIT_V(8); PG8_WAIT_L(0); PG8_BAR; PG8_MMA(1, 0, At, B0); PG8_MMA(1, 1, At, B1); PG8_BAR; PG8_SCHED;
        }
        if (wr == 0) PG8_BAR;
        E(acc, cur, wr, wc, fr, fq);
        if (!has_next) break;
#pragma unroll
        for (int a = 0; a < 2; ++a)
#pragma unroll
            for (int b = 0; b < 2; ++b)
#pragma unroll
                for (int m = 0; m < 4; ++m)
#pragma unroll
                    for (int n = 0; n < 2; ++n) acc[a][b][m][n] = (f32x4){0.f, 0.f, 0.f, 0.f};
        cur = nxt; cA = nA; cB = nB; ++ui;
        if (wr == 1) PG8_BAR;
    }
    PG8_WAIT_V(0);
    PG8_BAR;
#undef PG8_SA
#undef PG8_SB
#undef PG8_STAGE
#undef PG8_LDA
#undef PG8_LDB
#undef PG8_MMA
#undef PG8_WAIT_V
#undef PG8_WAIT_L
#undef PG8_BAR
#undef PG8_SCHED
}
}

struct Params {
    const float* x; const float* ln_g; const float* ln_b;
    const float* ffn1_in; const float* ffn1_out; const float* ffn2_in; const float* ffn2_out;
    const float* ret_in; const float* gn_g; const float* gn_b; const float* ret_out;
    const float* kv_w; const float* cmp_pos; const float* cmp_w1; const float* cmp_b1; const float* cmp_w2;
    const float* nsa_q; const float* nsa_out;
    float* out; unsigned char* ws;
    int ph_lo, ph_hi;
};

__device__ __forceinline__ int dest_row(int n, int mode) { if (mode == 0) return n; const int isu = n >= FF ? 1 : 0, j = n - isu * FF; return (j >> 7) * 256 + isu * 128 + (j & 127); }
__device__ __forceinline__ void transpose_item(const float* W, int K, int N, bf16_t* WT, int mode, LAS float* scr, int item, int nblk, int lane) {
    const int kb = item / nblk, nb = item % nblk, k0 = 64 * kb, n0 = 32 * nb;
    const int nn = n0 + (lane & 31); const bool inb = nn < N;
#pragma unroll 8
    for (int i = 0; i < 32; ++i) { const int kk = 2 * i + (lane >> 5); scr[kk * 33 + (lane & 31)] = inb ? W[(size_t)(k0 + kk) * N + nn] : 0.f; }
    asm volatile("s_waitcnt lgkmcnt(0)" ::: "memory");
    const int c = lane & 7;
#pragma unroll
    for (int j = 0; j < 4; ++j) { const int n = (lane >> 3) + 8 * j; const LAS float* s = scr + (8 * c) * 33 + n;
        u32x4 o; o.x = pk2(s[0 * 33], s[1 * 33]); o.y = pk2(s[2 * 33], s[3 * 33]); o.z = pk2(s[4 * 33], s[5 * 33]); o.w = pk2(s[6 * 33], s[7 * 33]);
        *(u32x4*)(WT + (size_t)dest_row(n0 + n, mode) * K + k0 + 8 * c) = o; }
    asm volatile("s_waitcnt lgkmcnt(0)" ::: "memory");
}
__device__ __forceinline__ void convert_one(ldsp lds, const float* W, int K, int N, int Npad, int mode, bf16_t* WT) {
    const int tid = opaque_tid(), lane = tid & 63, wave = rfl(tid >> 6);
    LAS float* scr = (LAS float*)(lds + wave * 8448);
    const int gw = blockIdx.x * 8 + wave, NGW = gridDim.x * 8;
    const int nblk = Npad / 32, nitems = (K / 64) * nblk;
    for (int it = gw; it < nitems; it += NGW) transpose_item(W, K, N, WT, mode, scr, it, nblk, lane);
}

__device__ __forceinline__ void ln_phase(const float* Y, float* X, bf16_t* Xb, const float* g, const float* b) {
    const int tid = opaque_tid(), lane = tid & 63, wave = rfl(tid >> 6);
    const int gw = blockIdx.x * 8 + wave, NGW = gridDim.x * 8;
    f32x4 gv[8], bv[8];
#pragma unroll
    for (int j = 0; j < 8; ++j) { gv[j] = *(const f32x4*)(g + 4 * lane + 256 * j); bv[j] = *(const f32x4*)(b + 4 * lane + 256 * j); }
    for (int m = gw; m < M; m += NGW) {
        const f32x4* yr = (const f32x4*)(Y + (size_t)m * D) + lane; f32x4 v[8]; float s = 0.f;
#pragma unroll
        for (int j = 0; j < 8; ++j) { v[j] = yr[64 * j]; s += (v[j][0] + v[j][1]) + (v[j][2] + v[j][3]); }
        const float mean = wave_sum(s) * (1.f / D); float s2 = 0.f;
#pragma unroll
        for (int j = 0; j < 8; ++j) { v[j] = v[j] - mean; s2 += (v[j][0] * v[j][0] + v[j][1] * v[j][1]) + (v[j][2] * v[j][2] + v[j][3] * v[j][3]); }
        const float rstd = 1.f / sqrtf(wave_sum(s2) * (1.f / D) + LN_EPS);
        f32x4* xr = (f32x4*)(X + (size_t)m * D) + lane; u32x2* br = (u32x2*)(Xb + (size_t)m * D) + lane;
#pragma unroll
        for (int j = 0; j < 8; ++j) { const f32x4 o = v[j] * rstd * gv[j] + bv[j]; xr[64 * j] = o; u32x2 w; w.x = pk2(o[0], o[1]); w.y = pk2(o[2], o[3]); br[64 * j] = w; }
    }
}

__device__ __forceinline__ void ret_phase(ldsp lds, bf16_t* R) {
    const int tid = opaque_tid(), lane = tid & 63, w = rfl(tid >> 6), li = lane & 15, g4 = lane >> 4, tq = li >> 2, tp = li & 3;
    constexpr int QS = 528, VS = 272, SS = 144;
    ldsp Qs = lds, Ks = lds + 64 * QS, Vs = lds + 128 * QS, Ss = lds + 128 * QS + 64 * VS;
    const int G = gridDim.x, vcu = vcu_of();
    for (int u = vcu; u < 256; u += G) {
        const int b = u >> 5, h = (u >> 2) & 7, vs = u & 3;
        const float l2g = __builtin_log2f(1.f - ex2(-5.f - (float)h));
        const float gC = ex2(l2g * (float)RC);
        f32x4 St[16];
#pragma unroll
        for (int k = 0; k < 16; ++k) St[k] = (f32x4){0.f, 0.f, 0.f, 0.f};
        bf16_t* Rb = R + (size_t)b * T * RETC;
        const int qc = h * 256, kc = 2048 + h * 256, vc = 4096 + h * 512 + vs * 128, vbase = 16 * w;
        for (int c = 0; c < T / RC; ++c) {
            bf16_t* Rc = Rb + (size_t)(RC * c) * RETC;
            __syncthreads();
#pragma unroll
            for (int i = 0; i < 4; ++i) { const int p = tid + 512 * i, r = p >> 5, ch = p & 31;
                const u32x4 qv = *(const u32x4*)(Rc + (size_t)r * RETC + qc + ch * 8), kv = *(const u32x4*)(Rc + (size_t)r * RETC + kc + ch * 8);
                *(LAS u32x4*)(Qs + r * QS + ch * 16) = qv; *(LAS u32x4*)(Ks + r * QS + ch * 16) = kv; }
#pragma unroll
            for (int i = 0; i < 2; ++i) { const int p = tid + 512 * i, r = p >> 4, ch = p & 15;
                const u32x4 vv = *(const u32x4*)(Rc + (size_t)r * RETC + vc + ch * 8); *(LAS u32x4*)(Vs + r * VS + ch * 16) = vv; }
            __syncthreads();
            {
                const int nt = w >> 1;
#pragma unroll
                for (int mt2 = 0; mt2 < 2; ++mt2) { const int mt = 2 * (w & 1) + mt2; f32x4 acc = (f32x4){0.f, 0.f, 0.f, 0.f};
                    if (mt <= nt) {
#pragma unroll
                        for (int ks = 0; ks < 8; ++ks) { const bf16x8 a = *(const LAS bf16x8*)(Qs + (16 * nt + li) * QS + (32 * ks + 8 * g4) * 2), bb = *(const LAS bf16x8*)(Ks + (16 * mt + li) * QS + (32 * ks + 8 * g4) * 2); acc = mfma16(a, bb, acc); }
                    }
#pragma unroll
                    for (int i = 0; i < 4; ++i) { const int n = 16 * nt + 4 * g4 + i, mm = 16 * mt + li; const float val = (mm <= n) ? acc[i] * ex2(l2g * (float)(n - (RC - 1))) : 0.f; *(LAS bf16_t*)(Ss + n * SS + mm * 2) = (bf16_t)f2bf(val); }
                }
            }
            __syncthreads();
            bf16x8 vf[2];
#pragma unroll
            for (int ms = 0; ms < 2; ++ms) { const s16x4 lo = trrd(Vs + (32 * ms + 8 * g4 + tq) * VS + (vbase + 4 * tp) * 2), hi = trrd(Vs + (32 * ms + 8 * g4 + 4 + tq) * VS + (vbase + 4 * tp) * 2); vf[ms] = cat8(lo, hi); }
            bf16x8 sb[8];
#pragma unroll
            for (int ks = 0; ks < 8; ++ks) { u32x4 wv; wv.x = pk2(St[2 * ks][0], St[2 * ks][1]); wv.y = pk2(St[2 * ks][2], St[2 * ks][3]); wv.z = pk2(St[2 * ks + 1][0], St[2 * ks + 1][1]); wv.w = pk2(St[2 * ks + 1][2], St[2 * ks + 1][3]); sb[ks] = __builtin_bit_cast(bf16x8, wv); }
#pragma unroll
            for (int nt = 0; nt < 4; ++nt) {
                f32x4 o = (f32x4){0.f, 0.f, 0.f, 0.f}, cr = (f32x4){0.f, 0.f, 0.f, 0.f};
#pragma unroll
                for (int ms = 0; ms < 2; ++ms) if (32 * ms <= 16 * nt + 15) { const bf16x8 a = *(const LAS bf16x8*)(Ss + (16 * nt + li) * SS + (32 * ms + 8 * g4) * 2); o = mfma16(a, vf[ms], o); }
#pragma unroll
                for (int ks = 0; ks < 8; ++ks) { const s16x4 lo = *(const LAS s16x4*)(Qs + (16 * nt + li) * QS + (32 * ks + 4 * g4) * 2), hi = *(const LAS s16x4*)(Qs + (16 * nt + li) * QS + (32 * ks + 16 + 4 * g4) * 2); cr = mfma16(cat8(lo, hi), sb[ks], cr); }
#pragma unroll
                for (int i = 0; i < 4; ++i) { const int n = 16 * nt + 4 * g4 + i; const float val = o[i] + ex2(l2g * (float)(n + 1)) * cr[i]; Rc[(size_t)n * RETC + vc + vbase + li] = (bf16_t)f2bf(val); }
            }
#pragma unroll
            for (int kt = 0; kt < 16; ++kt) { St[kt] = St[kt] * gC;
#pragma unroll
                for (int ms = 0; ms < 2; ++ms) { const s16x4 lo = trrd(Ks + (32 * ms + 8 * g4 + tq) * QS + (16 * kt + 4 * tp) * 2), hi = trrd(Ks + (32 * ms + 8 * g4 + 4 + tq) * QS + (16 * kt + 4 * tp) * 2); St[kt] = mfma16(cat8(lo, hi), vf[ms], St[kt]); }
            }
        }
    }
    __syncthreads();
}

__device__ __forceinline__ void gn_phase(bf16_t* R, const float* gg, const float* gb) {
    const int tid = opaque_tid(), lane = tid & 63, wave = rfl(tid >> 6);
    const int gw = blockIdx.x * 8 + wave, NGW = gridDim.x * 8;
    for (int it = gw; it < M * 8; it += NGW) {
        const int row = it >> 3, h = it & 7;
        bf16_t* op = R + (size_t)row * RETC + 4096 + h * 512 + 8 * lane; bf16_t* gp = op + 4096;
        const u32x4 ov = *(const u32x4*)op, gv = *(const u32x4*)gp;
        float o[8] = {bflo(ov.x), bfhi(ov.x), bflo(ov.y), bfhi(ov.y), bflo(ov.z), bfhi(ov.z), bflo(ov.w), bfhi(ov.w)};
        float gt[8] = {bflo(gv.x), bfhi(gv.x), bflo(gv.y), bfhi(gv.y), bflo(gv.z), bfhi(gv.z), bflo(gv.w), bfhi(gv.w)};
        float s = 0.f;
#pragma unroll
        for (int i = 0; i < 8; ++i) s += o[i];
        const float mean = wave_sum(s) * (1.f / 512.f); float s2 = 0.f;
#pragma unroll
        for (int i = 0; i < 8; ++i) { o[i] -= mean; s2 += o[i] * o[i]; }
        const float rstd = 1.f / sqrtf(wave_sum(s2) * (1.f / 512.f) + LN_EPS);
        const f32x4 g0 = *(const f32x4*)(gg + h * 512 + 8 * lane), g1 = *(const f32x4*)(gg + h * 512 + 8 * lane + 4), b0 = *(const f32x4*)(gb + h * 512 + 8 * lane), b1 = *(const f32x4*)(gb + h * 512 + 8 * lane + 4);
        float y[8];
#pragma unroll
        for (int i = 0; i < 8; ++i) { const float gi = i < 4 ? g0[i & 3] : g1[i & 3], bi = i < 4 ? b0[i & 3] : b1[i & 3]; y[i] = siluf(gt[i]) * (o[i] * rstd * gi + bi); }
        u32x4 w; w.x = pk2(y[0], y[1]); w.y = pk2(y[2], y[3]); w.z = pk2(y[4], y[5]); w.w = pk2(y[6], y[7]); *(u32x4*)gp = w;
    }
}

__device__ __forceinline__ void cmp_gather_phase(const bf16_t* KV, const float* cmp_pos, bf16_t* A) {
    const size_t gt = (size_t)blockIdx.x * 512 + threadIdx.x, NT = (size_t)gridDim.x * 512;
    for (size_t p = gt; p < (size_t)2 * 4096 * 512; p += NT) {
        const int dch = (int)(p & 15), l = (int)((p >> 4) & 31), Rr = (int)((p >> 9) & 4095), c = (int)(p >> 21);
        const int n = Rr & 127, bg = Rr >> 7, b = bg >> 2, g = bg & 3;
        u32x4 w = (u32x4){0u, 0u, 0u, 0u};
        if (n < 127) {
            const u32x4 kv = *(const u32x4*)(KV + (size_t)(b * T + 16 * n + l) * KVC + c * 512 + g * 128 + dch * 8);
            const float* pp = cmp_pos + (c * 32 + l) * 128 + dch * 8; const f32x4 p0 = *(const f32x4*)pp, p1 = *(const f32x4*)(pp + 4);
            w.x = pk2(bflo(kv.x) + p0[0], bfhi(kv.x) + p0[1]); w.y = pk2(bflo(kv.y) + p0[2], bfhi(kv.y) + p0[3]); w.z = pk2(bflo(kv.z) + p1[0], bfhi(kv.z) + p1[1]); w.w = pk2(bflo(kv.w) + p1[2], bfhi(kv.w) + p1[3]);
        }
        *(u32x4*)(A + ((size_t)c * 4096 + Rr) * 4096 + l * 128 + dch * 8) = w;
    }
}
__device__ __forceinline__ void cmp2_phase(const bf16_t* Hc, const float* W2, const float* ncos, const float* nsin, bf16_t* Kc, bf16_t* Vc) {
    const int gt = blockIdx.x * 512 + threadIdx.x, NT = gridDim.x * 512;
    for (int p = gt; p < 2 * 4096 * 16; p += NT) {
        const int dq = p & 15, Rr = (p >> 4) & 4095, c = p >> 16;
        const bf16_t* hr = Hc + ((size_t)c * 4096 + Rr) * 512; const float* w2 = W2 + (size_t)c * 512 * 128 + dq;
        float acc[8];
#pragma unroll
        for (int i = 0; i < 8; ++i) acc[i] = 0.f;
        for (int e0 = 0; e0 < 512; e0 += 8) {
            const u32x4 hv = *(const u32x4*)(hr + e0);
            const float hh[8] = {bflo(hv.x), bfhi(hv.x), bflo(hv.y), bfhi(hv.y), bflo(hv.z), bfhi(hv.z), bflo(hv.w), bfhi(hv.w)};
#pragma unroll
            for (int e = 0; e < 8; ++e)
#pragma unroll
                for (int i = 0; i < 8; ++i) acc[i] += hh[e] * w2[(size_t)(e0 + e) * 128 + 16 * i];
        }
        const int n = Rr & 127;
        if (c == 0) { const int pos = (16 * n + 31) & (T - 1); const float cs = ncos[pos * 16 + dq], sn = nsin[pos * 16 + dq]; const float x1 = acc[0], x2 = acc[1]; acc[0] = x1 * cs - x2 * sn; acc[1] = x2 * cs + x1 * sn; }
        bf16_t* o = (c == 0 ? Kc : Vc) + (size_t)Rr * 128 + dq;
#pragma unroll
        for (int i = 0; i < 8; ++i) o[16 * i] = (bf16_t)f2bf(acc[i]);
    }
}

constexpr int KSTR = 272;
__device__ __forceinline__ void load_tile64(ldsp dst, const bf16_t* src, int ld, int tid) {
#pragma unroll
    for (int i = 0; i < 2; ++i) { const int p = tid + 512 * i, r = p >> 4, ch = p & 15; const u32x4 v = *(const u32x4*)(src + (size_t)r * ld + ch * 8); *(LAS u32x4*)(dst + r * KSTR + ch * 16) = v; }
}
__device__ __forceinline__ void attn_step(ldsp Kt, ldsp Vt, const bf16x8 (&qf)[8], float& mrow, float& lrow, f32x16 (&Oc)[4], int kp0, int t, int lo, bool en, int ql, int h5, int lane) {
    f32x16 s[2];
#pragma unroll
    for (int kb = 0; kb < 2; ++kb) { s[kb] = (f32x16){};
#pragma unroll
        for (int ks = 0; ks < 8; ++ks) { const bf16x8 a = *(const LAS bf16x8*)(Kt + (32 * kb + ql) * KSTR + (16 * ks + 8 * h5) * 2); s[kb] = mfma32(a, qf[ks], s[kb]); }
        __builtin_amdgcn_sched_barrier(0); }
    float mx = -1e30f;
    const int hiL = t - kp0 - 4 * h5, loL = lo - kp0 - 4 * h5;
#pragma unroll
    for (int kb = 0; kb < 2; ++kb)
#pragma unroll
        for (int r = 0; r < 16; ++r) { const int cr = 32 * kb + (r & 3) + 8 * (r >> 2); const bool v = en && cr <= hiL && cr > loL; s[kb][r] = v ? s[kb][r] : -1e30f; mx = fmaxf(mx, s[kb][r]); }
    mx = fmaxf(mx, __shfl_xor(mx, 32));
    const float mnew = fmaxf(mrow, mx), al = ex2(mrow - mnew); mrow = mnew;
    float ps = 0.f;
#pragma unroll
    for (int kb = 0; kb < 2; ++kb)
#pragma unroll
        for (int r = 0; r < 16; ++r) { const float p = s[kb][r] > -1e29f ? ex2(s[kb][r] - mnew) : 0.f; s[kb][r] = p; ps += p; }
    lrow = lrow * al + ps;
#pragma unroll
    for (int d = 0; d < 4; ++d) Oc[d] = Oc[d] * al;
    const int li = lane & 15, tq = li >> 2, tp = li & 3, gi = (lane >> 4) & 1;
#pragma unroll
    for (int kb = 0; kb < 2; ++kb)
#pragma unroll
        for (int sx = 0; sx < 2; ++sx) {
            u32x4 pw; pw.x = pk2(s[kb][8 * sx + 0], s[kb][8 * sx + 1]); pw.y = pk2(s[kb][8 * sx + 2], s[kb][8 * sx + 3]); pw.z = pk2(s[kb][8 * sx + 4], s[kb][8 * sx + 5]); pw.w = pk2(s[kb][8 * sx + 6], s[kb][8 * sx + 7]);
            const bf16x8 pf = __builtin_bit_cast(bf16x8, pw);
            const int kbase = 32 * kb + 16 * sx + 4 * h5;
#pragma unroll
            for (int d = 0; d < 4; ++d) { const int cb = 32 * d + 16 * gi + 4 * tp;
                const s16x4 lo4 = trrd(Vt + (kbase + tq) * KSTR + cb * 2), hi4 = trrd(Vt + (kbase + 8 + tq) * KSTR + cb * 2);
                Oc[d] = mfma32(cat8(lo4, hi4), pf, Oc[d]); }
            __builtin_amdgcn_sched_barrier(0);
        }
}

__device__ __forceinline__ void nsa_phase(ldsp lds, const bf16_t* Qn, const bf16_t* KV, const bf16_t* Kc, const bf16_t* Vc, bf16_t* O) {
    const int tid = opaque_tid(), lane = tid & 63, w = rfl(tid >> 6), ql = lane & 31, h5 = lane >> 5;
    ldsp Kt = lds, Vt = lds + 128 * KSTR; LAS float* PS = (LAS float*)(lds + 256 * KSTR); LAS unsigned* SEL = (LAS unsigned*)(lds + 256 * KSTR + 32768); LAS unsigned* UNI = SEL + 64;
    const int G = gridDim.x, vcu = vcu_of();
    const int hh = w >> 1, th = w & 1, tqi = 32 * th + ql;
    for (int uu = vcu; uu < 1024; uu += G) {
        const int v8 = uu % 256, rnd = uu / 256; const int bg = v8 >> 3, s8 = v8 & 7; const int qb = rnd == 0 ? s8 : rnd == 1 ? 15 - s8 : rnd == 2 ? 16 + s8 : 31 - s8;
        const int b = bg >> 2, g = bg & 3;
        const int t = 64 * qb + tqi; const size_t row = (size_t)b * T + t;
        const bf16_t* qp = Qn + row * NQC + (4 * g + hh) * 128;
        bf16x8 qf[8];
#pragma unroll
        for (int ks = 0; ks < 8; ++ks) qf[ks] = *(const bf16x8*)(qp + 16 * ks + 8 * h5);
        float gate[3];
#pragma unroll
        for (int i = 0; i < 3; ++i) gate[i] = sigmf(bf2f(Qn[row * NQC + 2048 + (4 * g + hh) * 3 + i]));
        unsigned Oa[4][8];
        __syncthreads();
        load_tile64(Kt, Kc + (size_t)bg * 128 * 128, 128, tid); load_tile64(Kt + 64 * KSTR, Kc + (size_t)bg * 128 * 128 + 64 * 128, 128, tid);
        load_tile64(Vt, Vc + (size_t)bg * 128 * 128, 128, tid); load_tile64(Vt + 64 * KSTR, Vc + (size_t)bg * 128 * 128 + 64 * 128, 128, tid);
        if (tid == 0) UNI[0] = 0u;
        __syncthreads();
        {
            f32x16 s[4]; float mx = -1e30f;
            const int nlim = min(126, (t - 31) >> 4) - 4 * h5;
#pragma unroll
            for (int kb = 0; kb < 4; ++kb) { s[kb] = (f32x16){};
#pragma unroll
                for (int ks = 0; ks < 8; ++ks) { const bf16x8 a = *(const LAS bf16x8*)(Kt + (32 * kb + ql) * KSTR + (16 * ks + 8 * h5) * 2); s[kb] = mfma32(a, qf[ks], s[kb]); }
#pragma unroll
                for (int r = 0; r < 16; ++r) { const int cn = 32 * kb + (r & 3) + 8 * (r >> 2); const bool v = cn <= nlim; s[kb][r] = v ? s[kb][r] : -1e30f; mx = fmaxf(mx, s[kb][r]); } }
            mx = fmaxf(mx, __shfl_xor(mx, 32));
            float ps = 0.f;
#pragma unroll
            for (int kb = 0; kb < 4; ++kb)
#pragma unroll
                for (int r = 0; r < 16; ++r) { const float p = s[kb][r] > -1e29f ? ex2(s[kb][r] - mx) : 0.f; s[kb][r] = p; ps += p; }
            ps += __shfl_xor(ps, 32);
            const float inv = ps > 0.f ? 1.f / ps : 0.f;
            float Gs[16], Es[16];
#pragma unroll
            for (int kb = 0; kb < 4; ++kb)
#pragma unroll
                for (int rr = 0; rr < 4; ++rr) { float a0 = s[kb][4 * rr] * inv, a1 = s[kb][4 * rr + 1] * inv, a2 = s[kb][4 * rr + 2] * inv, a3 = s[kb][4 * rr + 3] * inv;
                    s[kb][4 * rr] = a0; s[kb][4 * rr + 1] = a1; s[kb][4 * rr + 2] = a2; s[kb][4 * rr + 3] = a3; Gs[kb * 4 + rr] = (a0 + a1) + (a2 + a3); Es[kb * 4 + rr] = a3; }
            float prevE = 0.f;
#pragma unroll
            for (int idx = 0; idx < 16; ++idx) { const float ep = __shfl_xor(Es[idx], 32); const float val = Gs[idx] + (h5 ? ep : prevE); prevE = ep;
                const int j = 8 * (idx >> 2) + 2 * (idx & 3) + h5; PS[(hh * 64 + tqi) * 32 + j] = val; }
            f32x16 Oc[4];
#pragma unroll
            for (int d = 0; d < 4; ++d) Oc[d] = (f32x16){};
            const int li = lane & 15, tq = li >> 2, tp = li & 3, gi = (lane >> 4) & 1;
#pragma unroll
            for (int kb = 0; kb < 4; ++kb)
#pragma unroll
                for (int sx = 0; sx < 2; ++sx) {
                    u32x4 pw; pw.x = pk2(s[kb][8 * sx + 0], s[kb][8 * sx + 1]); pw.y = pk2(s[kb][8 * sx + 2], s[kb][8 * sx + 3]); pw.z = pk2(s[kb][8 * sx + 4], s[kb][8 * sx + 5]); pw.w = pk2(s[kb][8 * sx + 6], s[kb][8 * sx + 7]);
                    const bf16x8 pf = __builtin_bit_cast(bf16x8, pw); const int kbase = 32 * kb + 16 * sx + 4 * h5;
#pragma unroll
                    for (int d = 0; d < 4; ++d) { const int cb = 32 * d + 16 * gi + 4 * tp;
                        const s16x4 lo4 = trrd(Vt + (kbase + tq) * KSTR + cb * 2), hi4 = trrd(Vt + (kbase + 8 + tq) * KSTR + cb * 2);
                        Oc[d] = mfma32(cat8(lo4, hi4), pf, Oc[d]); }
                    __builtin_amdgcn_sched_barrier(0);
                }
#pragma unroll
            for (int d = 0; d < 4; ++d)
#pragma unroll
                for (int r = 0; r < 8; ++r) Oa[d][r] = pk2(Oc[d][2 * r] * gate[0], Oc[d][2 * r + 1] * gate[0]);
        }
        __syncthreads();
        if (tid < 64) {
            float sc[32];
#pragma unroll
            for (int j = 0; j < 32; ++j) sc[j] = (PS[(0 * 64 + tid) * 32 + j] + PS[(1 * 64 + tid) * 32 + j]) + (PS[(2 * 64 + tid) * 32 + j] + PS[(3 * 64 + tid) * 32 + j]);
            const int cur = qb; unsigned sel = 1u | (1u << cur) | (cur > 0 ? (1u << (cur - 1)) : 0u);
            const int need = 8 - __builtin_popcount(sel);
#pragma unroll
            for (int it = 0; it < 5; ++it) if (it < need) { float best = -1.f; int bj = -1;
#pragma unroll
                for (int j = 1; j < 32; ++j) { const bool ok = (j <= cur - 2) && !((sel >> j) & 1u); if (ok && sc[j] > best) { best = sc[j]; bj = j; } }
                if (bj >= 0) sel |= 1u << bj; }
            SEL[tid] = sel; atomicOr((unsigned*)UNI, sel);
        }
        __syncthreads();
        const unsigned mysel = SEL[tqi], uni = UNI[0];
        {
            float mrow = -1e30f, lrow = 0.f; f32x16 Oc[4];
#pragma unroll
            for (int d = 0; d < 4; ++d) Oc[d] = (f32x16){};
            for (int j = 0; j <= qb; ++j) { if (!((uni >> j) & 1u)) continue;
                __syncthreads();
                const bf16_t* kb_ = KV + ((size_t)b * T + 64 * j) * KVC + g * 128;
                load_tile64(Kt, kb_ + 2 * 512, KVC, tid); load_tile64(Vt, kb_ + 3 * 512, KVC, tid);
                __syncthreads();
                attn_step(Kt, Vt, qf, mrow, lrow, Oc, 64 * j, t, -1, ((mysel >> j) & 1u) != 0u, ql, h5, lane);
            }
            lrow += __shfl_xor(lrow, 32); const float sc = gate[1] / lrow;
#pragma unroll
            for (int d = 0; d < 4; ++d)
#pragma unroll
                for (int r = 0; r < 8; ++r) Oa[d][r] = pk2(bflo(Oa[d][r]) + Oc[d][2 * r] * sc, bfhi(Oa[d][r]) + Oc[d][2 * r + 1] * sc);
        }
        {
            float mrow = -1e30f, lrow = 0.f; f32x16 Oc[4];
#pragma unroll
            for (int d = 0; d < 4; ++d) Oc[d] = (f32x16){};
            for (int j = (qb > 8 ? qb - 8 : 0); j <= qb; ++j) {
                __syncthreads();
                const bf16_t* kb_ = KV + ((size_t)b * T + 64 * j) * KVC + g * 128;
                load_tile64(Kt, kb_ + 4 * 512, KVC, tid); load_tile64(Vt, kb_ + 5 * 512, KVC, tid);
                __syncthreads();
                attn_step(Kt, Vt, qf, mrow, lrow, Oc, 64 * j, t, t - 512, true, ql, h5, lane);
            }
            lrow += __shfl_xor(lrow, 32); const float sc = gate[2] / lrow;
            bf16_t* op = O + row * D + (4 * g + hh) * 128 + 4 * h5;
#pragma unroll
            for (int d = 0; d < 4; ++d)
#pragma unroll
                for (int rr = 0; rr < 4; ++rr) { u32x2 wv;
                    wv.x = pk2(bflo(Oa[d][2 * rr]) + Oc[d][4 * rr] * sc, bfhi(Oa[d][2 * rr]) + Oc[d][4 * rr + 1] * sc);
                    wv.y = pk2(bflo(Oa[d][2 * rr + 1]) + Oc[d][4 * rr + 2] * sc, bfhi(Oa[d][2 * rr + 1]) + Oc[d][4 * rr + 3] * sc);
                    *(u32x2*)(op + 32 * d + 8 * rr) = wv; }
        }
    }
    __syncthreads();
}

#ifndef COSF
#define COSF cosf
#define SINF sinf
#endif
#ifndef GMASK
#define GMASK 0xffff
#endif
constexpr int NPHASE = 26;
typedef const __attribute__((address_space(4))) Params* cparams_t;
__device__ __forceinline__ cparams_t kparams() { const __attribute__((address_space(4))) void* q = (const __attribute__((address_space(4))) void*)__builtin_amdgcn_kernarg_segment_ptr(); asm volatile("" : "+s"(q)); return (cparams_t)q; }
#define PHASE_BEGIN if (lo <= ph && ph < hi) { cparams_t pp = kparams(); unsigned char* ws = pp->ws; bf16_t* Xb = (bf16_t*)(ws + WS_XB); bf16_t* KVb = (bf16_t*)(ws + WS_KV); bf16_t* R = (bf16_t*)(ws + WS_R); bf16_t* Hb = (bf16_t*)(ws + WS_R + R_H); \
    float* rcos = (float*)(ws + WS_ROPE_R); float* rsin = rcos + 2048 * 128; float* ncos = (float*)(ws + WS_ROPE_N); float* nsin = ncos + 2048 * 16; (void)Xb; (void)KVb; (void)R; (void)Hb; (void)rcos; (void)rsin; (void)ncos; (void)nsin;
#define PHASE_END } if (lo <= ph && ph + 1 < hi) grid.sync(); ++ph;

template <int layer> __device__ __forceinline__ void run_layer(ldsp lds, cg::grid_group& grid, const int lo, const int hi, int& ph, const int G) {
        PHASE_BEGIN
            pg8::Gemm g{Xb, (const bf16_t*)(ws + W_FFN1_IN), M, 2 * FF, D, D}; pg8::StaticOrder S; S.init(M, 2 * FF, G, (int)blockIdx.x);
            pg8::Epi<pg8::EPI_SWIGLU> E{Hb, nullptr, FF, 0.f, 0.f, nullptr, nullptr};
            if (GMASK & (1 << 0)) pg8::gemm_phase(lds, g, S, E);
        PHASE_END
        PHASE_BEGIN
            pg8::Gemm g{Hb, (const bf16_t*)(ws + W_FFN1_OUT), M, D, FF, FF}; pg8::StaticOrder S; S.init(M, D, G, (int)blockIdx.x);
            pg8::Epi<pg8::EPI_RESID> E{pp->out, layer == 0 ? pp->x : pp->out, D, ALPHA, 0.5f, nullptr, nullptr};
            if (GMASK & (1 << 1)) pg8::gemm_phase(lds, g, S, E);
        PHASE_END
        PHASE_BEGIN
            ln_phase(pp->out, pp->out, Xb, pp->ln_g + layer * 3 * D, pp->ln_b + layer * 3 * D);
        PHASE_END
        if constexpr (layer == 0) {
            PHASE_BEGIN
                pg8::Gemm g{Xb, (const bf16_t*)(ws + W_RET_IN), M, RETC, D, D}; pg8::StaticOrder S; S.init(M, RETC, G, (int)blockIdx.x);
                pg8::Epi<pg8::EPI_RET> E{R, nullptr, RETC, 0.f, 0.f, rcos, rsin};
                if (GMASK & (1 << 2)) pg8::gemm_phase(lds, g, S, E);
            PHASE_END
            PHASE_BEGIN
#ifndef SKIP_RET
                ret_phase(lds, R);
#endif
            PHASE_END
            PHASE_BEGIN
                gn_phase(R, pp->gn_g, pp->gn_b);
            PHASE_END
            PHASE_BEGIN
                pg8::Gemm g{R + 8192, (const bf16_t*)(ws + W_RET_OUT), M, D, 4096, RETC}; pg8::StaticOrder S; S.init(M, D, G, (int)blockIdx.x);
                pg8::Epi<pg8::EPI_RESID> E{pp->out, pp->out, D, ALPHA, 1.0f, nullptr, nullptr};
                if (GMASK & (1 << 3)) pg8::gemm_phase(lds, g, S, E);
            PHASE_END
        } else {
            PHASE_BEGIN
                pg8::Gemm g{Xb, (const bf16_t*)(ws + W_NSA_Q), M, NQC, D, D}; pg8::StaticOrder S; S.init(M, NQC, G, (int)blockIdx.x);
                pg8::Epi<pg8::EPI_NSAQ> E{(bf16_t*)(ws + WS_R + R_QN), nullptr, NQC, QSCALE, 0.f, ncos, nsin};
                if (GMASK & (1 << 4)) pg8::gemm_phase(lds, g, S, E);
            PHASE_END
            PHASE_BEGIN
#ifndef SKIP_NSA
                nsa_phase(lds, (const bf16_t*)(ws + WS_R + R_QN), KVb, (const bf16_t*)(ws + WS_KC), (const bf16_t*)(ws + WS_VC), (bf16_t*)(ws + WS_R + R_O));
#endif
            PHASE_END
            PHASE_BEGIN
            PHASE_END
            PHASE_BEGIN
                pg8::Gemm g{(const bf16_t*)(ws + WS_R + R_O), (const bf16_t*)(ws + W_NSA_OUT), M, D, D, D}; pg8::StaticOrder S; S.init(M, D, G, (int)blockIdx.x);
                pg8::Epi<pg8::EPI_RESID> E{pp->out, pp->out, D, ALPHA, 1.0f, nullptr, nullptr};
                if (GMASK & (1 << 5)) pg8::gemm_phase(lds, g, S, E);
            PHASE_END
        }
        PHASE_BEGIN
            ln_phase(pp->out, pp->out, Xb, pp->ln_g + layer * 3 * D + D, pp->ln_b + layer * 3 * D + D);
        PHASE_END
        PHASE_BEGIN
            pg8::Gemm g{Xb, (const bf16_t*)(ws + W_FFN2_IN), M, 2 * FF, D, D}; pg8::StaticOrder S; S.init(M, 2 * FF, G, (int)blockIdx.x);
            pg8::Epi<pg8::EPI_SWIGLU> E{Hb, nullptr, FF, 0.f, 0.f, nullptr, nullptr};
            if (GMASK & (1 << 6)) pg8::gemm_phase(lds, g, S, E);
        PHASE_END
        PHASE_BEGIN
            pg8::Gemm g{Hb, (const bf16_t*)(ws + W_FFN2_OUT), M, D, FF, FF}; pg8::StaticOrder S; S.init(M, D, G, (int)blockIdx.x);
            pg8::Epi<pg8::EPI_RESID> E{pp->out, pp->out, D, ALPHA, 0.5f, nullptr, nullptr};
            if (GMASK & (1 << 7)) pg8::gemm_phase(lds, g, S, E);
        PHASE_END
        PHASE_BEGIN
            ln_phase(pp->out, pp->out, Xb, pp->ln_g + layer * 3 * D + 2 * D, pp->ln_b + layer * 3 * D + 2 * D);
        PHASE_END
        if constexpr (layer == 0) {
            PHASE_BEGIN
                pg8::Gemm g{Xb, (const bf16_t*)(ws + W_KV), M, KVC, D, D}; pg8::StaticOrder S; S.init(M, KVC, G, (int)blockIdx.x);
                pg8::Epi<pg8::EPI_KV> E{KVb, nullptr, KVC, 1.f, 0.f, ncos, nsin};
                if (GMASK & (1 << 8)) pg8::gemm_phase(lds, g, S, E);
            PHASE_END
            PHASE_BEGIN
                cmp_gather_phase(KVb, pp->cmp_pos, (bf16_t*)(ws + WS_R + R_ACMP));
            PHASE_END
            PHASE_BEGIN
                pg8::Gemm g{(const bf16_t*)(ws + WS_R + R_ACMP), (const bf16_t*)(ws + W_CMP1), 8192, 1024, 4096, 4096}; pg8::CmpOrder S{G, (int)blockIdx.x};
                pg8::Epi<pg8::EPI_CMP1> E{(bf16_t*)(ws + WS_R + R_HC), pp->cmp_b1, 512, 0.f, 0.f, nullptr, nullptr};
                if (GMASK & (1 << 9)) pg8::gemm_phase(lds, g, S, E);
            PHASE_END
            PHASE_BEGIN
                cmp2_phase((const bf16_t*)(ws + WS_R + R_HC), pp->cmp_w2, ncos, nsin, (bf16_t*)(ws + WS_KC), (bf16_t*)(ws + WS_VC));
                __syncthreads();
                convert_one(lds, pp->ffn1_in + (size_t)D * 2 * FF, D, 2 * FF, 2 * FF, 1, (bf16_t*)(ws + W_FFN1_IN));
                convert_one(lds, pp->ffn1_out + (size_t)FF * D, FF, D, D, 0, (bf16_t*)(ws + W_FFN1_OUT));
                convert_one(lds, pp->ffn2_in + (size_t)D * 2 * FF, D, 2 * FF, 2 * FF, 1, (bf16_t*)(ws + W_FFN2_IN));
                convert_one(lds, pp->ffn2_out + (size_t)FF * D, FF, D, D, 0, (bf16_t*)(ws + W_FFN2_OUT));
                convert_one(lds, pp->nsa_q, D, 2096, NQC, 0, (bf16_t*)(ws + W_NSA_Q));
                convert_one(lds, pp->nsa_out, D, D, D, 0, (bf16_t*)(ws + W_NSA_OUT));
            PHASE_END
        }
    }

__global__ void __launch_bounds__(512, 2) yoco_fwd(Params p) {
    extern __shared__ __attribute__((aligned(16))) unsigned char lds_raw[];
    ldsp lds = (ldsp)lds_raw;
    cg::grid_group grid = cg::this_grid();
    const int G = gridDim.x;
    const int lo = p.ph_lo, hi = p.ph_hi;
    int ph = 0;
    PHASE_BEGIN
        convert_one(lds, pp->ffn1_in, D, 2 * FF, 2 * FF, 1, (bf16_t*)(ws + W_FFN1_IN));
        convert_one(lds, pp->ffn1_out, FF, D, D, 0, (bf16_t*)(ws + W_FFN1_OUT));
        convert_one(lds, pp->ffn2_in, D, 2 * FF, 2 * FF, 1, (bf16_t*)(ws + W_FFN2_IN));
        convert_one(lds, pp->ffn2_out, FF, D, D, 0, (bf16_t*)(ws + W_FFN2_OUT));
        convert_one(lds, pp->ret_in, D, RETC, RETC, 0, (bf16_t*)(ws + W_RET_IN));
        convert_one(lds, pp->ret_out, 4096, D, D, 0, (bf16_t*)(ws + W_RET_OUT));
        convert_one(lds, pp->kv_w, D, KVC, KVC, 0, (bf16_t*)(ws + W_KV));
        convert_one(lds, pp->cmp_w1, 4096, 512, 512, 0, (bf16_t*)(ws + W_CMP1));
        convert_one(lds, pp->cmp_w1 + (size_t)4096 * 512, 4096, 512, 512, 0, (bf16_t*)(ws + W_CMP1) + (size_t)512 * 4096);
        const size_t gt = (size_t)blockIdx.x * 512 + threadIdx.x, NT = (size_t)G * 512;
        for (size_t i = gt; i < (size_t)2048 * 128; i += NT) { const int pos = (int)(i >> 7), f = (int)(i & 127); const float inv = powf(10000.f, -(float)f / 128.f); const float ang = (float)pos * inv; rcos[i] = COSF(ang); rsin[i] = SINF(ang); }
        for (size_t i = gt; i < (size_t)2048 * 16; i += NT) { const int pos = (int)(i >> 4), f = (int)(i & 15); const float inv = powf(500000.f, -(float)f / 16.f); const float ang = (float)pos * inv; ncos[i] = COSF(ang); nsin[i] = SINF(ang); }
        for (size_t i = gt; i < (size_t)M * D / 8; i += NT) { const f32x4 a = *(const f32x4*)(pp->x + i * 8), b2 = *(const f32x4*)(pp->x + i * 8 + 4); u32x4 w; w.x = pk2(a[0], a[1]); w.y = pk2(a[2], a[3]); w.z = pk2(b2[0], b2[1]); w.w = pk2(b2[2], b2[3]); *(u32x4*)(Xb + i * 8) = w; }
    PHASE_END

    run_layer<0>(lds, grid, lo, hi, ph, G);
    run_layer<1>(lds, grid, lo, hi, ph, G);
#undef PHASE_BEGIN
#undef PHASE_END
}

#ifndef N_LAUNCH_MODE
#define N_LAUNCH_MODE 1
#endif
extern "C" void kernel_launch(void* const* d_in, const int* in_sizes, int n_in, void* d_out, int out_size, void* d_ws, size_t ws_size, hipStream_t stream) {
    static int inited = 0;
    if (!inited) { (void)hipFuncSetAttribute((const void*)yoco_fwd, hipFuncAttributeMaxDynamicSharedMemorySize, LDS_BYTES); inited = 1; }
    Params p{};
    p.x = (const float*)d_in[0]; p.ln_g = (const float*)d_in[1]; p.ln_b = (const float*)d_in[2];
    p.ffn1_in = (const float*)d_in[3]; p.ffn1_out = (const float*)d_in[4]; p.ffn2_in = (const float*)d_in[5]; p.ffn2_out = (const float*)d_in[6];
    p.ret_in = (const float*)d_in[7]; p.gn_g = (const float*)d_in[8]; p.gn_b = (const float*)d_in[9]; p.ret_out = (const float*)d_in[10];
    p.kv_w = (const float*)d_in[11]; p.cmp_pos = (const float*)d_in[12]; p.cmp_w1 = (const float*)d_in[13]; p.cmp_b1 = (const float*)d_in[14]; p.cmp_w2 = (const float*)d_in[15];
    p.nsa_q = (const float*)d_in[16]; p.nsa_out = (const float*)d_in[17];
    p.out = (float*)d_out; p.ws = (unsigned char*)d_ws;
#if N_LAUNCH_MODE == 1
    p.ph_lo = 0; p.ph_hi = 64;
    void* args[] = {&p};
    hipError_t e = hipLaunchCooperativeKernel((const void*)yoco_fwd, dim3(256), dim3(512), args, LDS_BYTES, stream);
    if (e != hipSuccess) fprintf(stderr, "cooperative launch failed: %s\n", hipGetErrorString(e));
#else
    for (int ph = 0; ph < 32; ++ph) { p.ph_lo = ph; p.ph_hi = ph + 1; hipLaunchKernelGGL(yoco_fwd, dim3(256), dim3(512), LDS_BYTES, stream, p); }
#endif
}
```

```cpp
#include <hip/hip_runtime.h>
#include <hip/hip_cooperative_groups.h>
#include <cstdint>
#include <cstdio>
namespace cg = cooperative_groups;

#define LAS __attribute__((address_space(3)))
typedef unsigned short bf16_t;
typedef short bf16x8 __attribute__((ext_vector_type(8)));
typedef short s16x4 __attribute__((ext_vector_type(4)));
typedef float f32x4 __attribute__((ext_vector_type(4)));
typedef float f32x16 __attribute__((ext_vector_type(16)));
typedef unsigned u32x4 __attribute__((ext_vector_type(4)));
typedef unsigned u32x2 __attribute__((ext_vector_type(2)));
typedef LAS unsigned char* ldsp;

constexpr int BATCH = 8, T = 2048, D = 2048, M = BATCH * T, FF = 5632;
constexpr int RETC = 12288;
constexpr int KVC = 3072, NQC = 2304;
constexpr float ALPHA = 1.41421356237f, LN_EPS = 1e-5f;
constexpr float QSCALE = 0.08838834764831845f * 1.4426950408889634f;
constexpr int RC = 64;

constexpr size_t MiB = 1u << 20;
constexpr size_t W_FFN1_IN = 0;
constexpr size_t W_FFN1_OUT = W_FFN1_IN + (size_t)2 * FF * D * 2;
constexpr size_t W_FFN2_IN = W_FFN1_OUT + (size_t)D * FF * 2;
constexpr size_t W_FFN2_OUT = W_FFN2_IN + (size_t)2 * FF * D * 2;
constexpr size_t W_X0 = W_FFN2_OUT + (size_t)D * FF * 2;
constexpr size_t W_RET_IN = W_X0;
constexpr size_t W_RET_OUT = W_RET_IN + (size_t)RETC * D * 2;
constexpr size_t W_KV = W_RET_OUT + (size_t)D * 4096 * 2;
constexpr size_t W_CMP1 = W_KV + (size_t)KVC * D * 2;
constexpr size_t W_END0 = W_CMP1 + (size_t)1024 * 4096 * 2;
constexpr size_t W_NSA_Q = W_X0;
constexpr size_t W_NSA_OUT = W_NSA_Q + (size_t)NQC * D * 2;
constexpr size_t WS_XB = 216 * MiB;
constexpr size_t WS_KV = 280 * MiB;
constexpr size_t WS_R = 376 * MiB;
constexpr size_t WS_KC = 760 * MiB, WS_VC = 761 * MiB;
constexpr size_t WS_ROPE_R = 762 * MiB;
constexpr size_t WS_ROPE_N = 764 * MiB;
static_assert(W_END0 <= WS_XB, "weights region");
constexpr size_t R_H = 0;
constexpr size_t R_ACMP = 0;
constexpr size_t R_HC = 64 * MiB;
constexpr size_t R_QN = 0;
constexpr size_t R_O = 72 * MiB;

constexpr int LDS_BYTES = 135168;

__device__ __forceinline__ int opaque_tid() { int t = threadIdx.x; asm volatile("" : "+v"(t)); return t; }
__device__ __forceinline__ int rfl(int v) { return __builtin_amdgcn_readfirstlane(v); }
__device__ __forceinline__ unsigned f2bf(float f) { unsigned u = __builtin_bit_cast(unsigned, f); return (u + 0x7fffu + ((u >> 16) & 1u)) >> 16; }
__device__ __forceinline__ unsigned pk2(float lo, float hi) { unsigned r; asm volatile("v_cvt_pk_bf16_f32 %0, %1, %2" : "=v"(r) : "v"(lo), "v"(hi)); return r; }
__device__ __forceinline__ float bf2f(unsigned short b) { return __builtin_bit_cast(float, (unsigned)b << 16); }
__device__ __forceinline__ float bflo(unsigned w) { return __builtin_bit_cast(float, w << 16); }
__device__ __forceinline__ float bfhi(unsigned w) { return __builtin_bit_cast(float, w & 0xffff0000u); }
__device__ __forceinline__ float ex2(float x) { return __builtin_amdgcn_exp2f(x); }
__device__ __forceinline__ float siluf(float a) { return a * __builtin_amdgcn_rcpf(1.f + ex2(-1.4426950408889634f * a)); }
__device__ __forceinline__ float sigmf(float a) { return __builtin_amdgcn_rcpf(1.f + ex2(-1.4426950408889634f * a)); }
__device__ __forceinline__ float gelu_tanh(float x) {
    const float u = 0.7978845608028654f * (x + 0.044715f * x * x * x);
    const float e = ex2(2.8853900817779268f * u);
    const float th = 1.f - 2.f * __builtin_amdgcn_rcpf(e + 1.f);
    return 0.5f * x * (1.f + th);
}
__device__ __forceinline__ float wave_sum(float v) {
#pragma unroll
    for (int o = 1; o < 64; o <<= 1) v += __shfl_xor(v, o);
    return v;
}
__device__ __forceinline__ f32x4 mfma16(bf16x8 a, bf16x8 b, f32x4 c) { return __builtin_amdgcn_mfma_f32_16x16x32_bf16(a, b, c, 0, 0, 0); }
__device__ __forceinline__ f32x16 mfma32(bf16x8 a, bf16x8 b, f32x16 c) { return __builtin_amdgcn_mfma_f32_32x32x16_bf16(a, b, c, 0, 0, 0); }
typedef short v4i16_t __attribute__((ext_vector_type(4)));
__device__ __forceinline__ s16x4 trrd(ldsp p) { return __builtin_bit_cast(s16x4, __builtin_amdgcn_ds_read_tr16_b64_v4i16((LAS v4i16_t*)p)); }
__device__ __forceinline__ bf16x8 cat8(s16x4 lo, s16x4 hi) { return (bf16x8){lo[0], lo[1], lo[2], lo[3], hi[0], hi[1], hi[2], hi[3]}; }
__device__ __forceinline__ int vcu_of() { const int G = gridDim.x, bx = blockIdx.x; return (G % 8 == 0) ? (bx % 8) * (G / 8) + bx / 8 : bx; }

namespace pg8 {
constexpr int BM = 256, BK = 64, HALF = 128, HTB = HALF * BK * 2, STAGE_BYTES = 8 * HTB, NXCD = 8, WGM = 8;
__host__ __device__ __forceinline__ int lds_byte(int r, int c) { const int st = (r >> 4) * 2 + (c >> 5), rr = r & 15, cc = c & 31, ob = rr * 64 + cc * 2; return st * 1024 + (ob ^ (((ob >> 9) & 1) << 5)); }
__host__ __device__ __forceinline__ void stage_rc(int b, int& R, int& C) { const int st = b / 1024, sb = b % 1024, swz = sb ^ (((sb >> 9) & 1) << 5); R = (st >> 1) * 16 + swz / 64; C = (st & 1) * 32 + (swz % 64) / 2; }
__host__ __device__ __forceinline__ int perm32(int rho) { const int n = rho >> 4, i = rho & 15; return 8 * (i >> 2) + 4 * n + (i & 3); }
struct Unit { int pm, pn; };
struct Gemm { const bf16_t* A; const bf16_t* Bt; int M, N, K, lda; };
struct StaticOrder {
    int nM, nN, nwg, G, c;
    __device__ void init(int M_, int N_, int G_, int c_) { nM = M_ / BM; nN = N_ / BM; nwg = nM * nN; G = G_; c = c_; }
    __device__ bool next(int i, Unit& u) const {
        const long L = (long)i * G + c; if (L >= nwg) return false;
        int wgid = (int)L; { const int q = nwg / NXCD, r = nwg % NXCD, xcd = wgid % NXCD, off = wgid / NXCD; wgid = (xcd < r ? xcd * (q + 1) : r * (q + 1) + (xcd - r) * q) + off; }
        const int nig = WGM * nN, gid = wgid / nig, fm = gid * WGM, gsz = (nM - fm) < WGM ? (nM - fm) : WGM;
        u.pm = fm + ((wgid % nig) % gsz); u.pn = (wgid % nig) / gsz; return true;
    }
};
struct CmpOrder {
    int G, c;
    __device__ bool next(int i, Unit& u) const { const int L = i * G + c; if (L >= 64) return false; const int cc = L >> 5, r = L & 31; u.pm = cc * 16 + (r >> 1); u.pn = cc * 2 + (r & 1); return true; }
};

enum { EPI_SWIGLU = 0, EPI_RESID = 1, EPI_RET = 2, EPI_KV = 3, EPI_NSAQ = 4, EPI_CMP1 = 5 };
template <int MODE> struct Epi {
    static constexpr bool PERM = (MODE == EPI_SWIGLU || MODE == EPI_RET || MODE == EPI_CMP1);
    void* out; const float* src; int ldc; float alpha, beta; const float* tcos; const float* tsin;
    __device__ __forceinline__ void operator()(const f32x4 (&acc)[2][2][4][2], const Unit& u, int wr, int wc, int fr, int fq) const {
        if constexpr (MODE == EPI_SWIGLU) {
            bf16_t* O = (bf16_t*)out; const int col0 = u.pn * 128 + wc * 32 + 8 * fq;
#pragma unroll
            for (int ai = 0; ai < 2; ++ai)
#pragma unroll
                for (int m = 0; m < 4; ++m) {
                    const int row = u.pm * BM + ai * HALF + wr * 64 + m * 16 + fr;
                    const f32x4 a0 = acc[ai][0][m][0], a1 = acc[ai][0][m][1], u0 = acc[ai][1][m][0], u1 = acc[ai][1][m][1];
                    u32x4 w; w.x = pk2(siluf(a0[0]) * u0[0], siluf(a0[1]) * u0[1]); w.y = pk2(siluf(a0[2]) * u0[2], siluf(a0[3]) * u0[3]);
                    w.z = pk2(siluf(a1[0]) * u1[0], siluf(a1[1]) * u1[1]); w.w = pk2(siluf(a1[2]) * u1[2], siluf(a1[3]) * u1[3]);
                    *(u32x4*)(O + (size_t)row * ldc + col0) = w;
                }
        } else if constexpr (MODE == EPI_RESID) {
            float* Y = (float*)out; const int col0 = u.pn * BM + wc * 32 + 4 * fq;
#pragma unroll
            for (int ai = 0; ai < 2; ++ai)
#pragma unroll
                for (int m = 0; m < 4; ++m) {
                    const int row = u.pm * BM + ai * HALF + wr * 64 + m * 16 + fr; const size_t off = (size_t)row * ldc + col0;
#pragma unroll
                    for (int bj = 0; bj < 2; ++bj)
#pragma unroll
                        for (int n = 0; n < 2; ++n) { const f32x4 x = *(const f32x4*)(src + off + bj * HALF + n * 16); *(f32x4*)(Y + off + bj * HALF + n * 16) = x * alpha + acc[ai][bj][m][n] * beta; }
                    asm volatile("" ::: "memory");
                }
        } else if constexpr (MODE == EPI_RET) {
            bf16_t* O = (bf16_t*)out; const int colw = wc * 32 + 8 * fq;
            if (u.pn < 16) {
                const bool isk = u.pn >= 8; const int hh = u.pn & 7; const float l2g = __builtin_log2f(1.f - ex2(-5.f - (float)hh));
#pragma unroll
                for (int ai = 0; ai < 2; ++ai)
#pragma unroll
                    for (int m = 0; m < 4; ++m) {
                        const int row = u.pm * BM + ai * HALF + wr * 64 + m * 16 + fr, pos = row & (T - 1);
                        const float sc = isk ? 0.0625f * ex2(l2g * (float)(RC - 1 - (pos & (RC - 1)))) : 1.f;
                        f32x4 o1[2], o2[2];
#pragma unroll
                        for (int n = 0; n < 2; ++n) { const f32x4 cs = *(const f32x4*)(tcos + pos * 128 + colw + 4 * n), sn = *(const f32x4*)(tsin + pos * 128 + colw + 4 * n);
                            const f32x4 x1 = acc[ai][0][m][n], x2 = acc[ai][1][m][n]; o1[n] = (x1 * cs - x2 * sn) * sc; o2[n] = (x2 * cs + x1 * sn) * sc; }
                        bf16_t* rp = O + (size_t)row * ldc + u.pn * BM + colw;
                        u32x4 w; w.x = pk2(o1[0][0], o1[0][1]); w.y = pk2(o1[0][2], o1[0][3]); w.z = pk2(o1[1][0], o1[1][1]); w.w = pk2(o1[1][2], o1[1][3]); *(u32x4*)rp = w;
                        w.x = pk2(o2[0][0], o2[0][1]); w.y = pk2(o2[0][2], o2[0][3]); w.z = pk2(o2[1][0], o2[1][1]); w.w = pk2(o2[1][2], o2[1][3]); *(u32x4*)(rp + HALF) = w;
                        asm volatile("" ::: "memory");
                    }
            } else {
#pragma unroll
                for (int ai = 0; ai < 2; ++ai)
#pragma unroll
                    for (int m = 0; m < 4; ++m) {
                        const int row = u.pm * BM + ai * HALF + wr * 64 + m * 16 + fr; bf16_t* rp = O + (size_t)row * ldc + u.pn * BM + colw;
#pragma unroll
                        for (int bj = 0; bj < 2; ++bj) { const f32x4 v0 = acc[ai][bj][m][0], v1 = acc[ai][bj][m][1]; u32x4 w; w.x = pk2(v0[0], v0[1]); w.y = pk2(v0[2], v0[3]); w.z = pk2(v1[0], v1[1]); w.w = pk2(v1[2], v1[3]); *(u32x4*)(rp + bj * HALF) = w; }
                    }
            }
        } else if constexpr (MODE == EPI_KV || MODE == EPI_NSAQ) {
            bf16_t* O = (bf16_t*)out;
            bool rope; float sc = 1.f;
            if constexpr (MODE == EPI_KV) { const int cidx = u.pn >> 1; rope = (cidx == 2 || cidx == 4) && wc == 0; }
            else { rope = (u.pn < 8) && wc == 0; sc = (u.pn < 8) ? alpha : 1.f; }
#pragma unroll
            for (int ai = 0; ai < 2; ++ai)
#pragma unroll
                for (int m = 0; m < 4; ++m) {
                    const int row = u.pm * BM + ai * HALF + wr * 64 + m * 16 + fr, pos = row & (T - 1);
                    f32x4 cs = (f32x4){1.f, 1.f, 1.f, 1.f}, sn = (f32x4){0.f, 0.f, 0.f, 0.f};
                    if (rope) { cs = *(const f32x4*)(tcos + pos * 16 + 4 * fq); sn = *(const f32x4*)(tsin + pos * 16 + 4 * fq); }
                    bf16_t* rp = O + (size_t)row * ldc + u.pn * BM + wc * 32 + 4 * fq;
#pragma unroll
                    for (int bj = 0; bj < 2; ++bj) { const f32x4 x1 = acc[ai][bj][m][0], x2 = acc[ai][bj][m][1];
                        const f32x4 o1 = (x1 * cs - x2 * sn) * sc, o2 = (x2 * cs + x1 * sn) * sc;
                        u32x2 w; w.x = pk2(o1[0], o1[1]); w.y = pk2(o1[2], o1[3]); *(u32x2*)(rp + bj * HALF) = w;
                        w.x = pk2(o2[0], o2[1]); w.y = pk2(o2[2], o2[3]); *(u32x2*)(rp + bj * HALF + 16) = w; }
                    asm volatile("" ::: "memory");
                }
        } else {
            bf16_t* O = (bf16_t*)out; const int colw = wc * 32 + 8 * fq;
#pragma unroll
            for (int ai = 0; ai < 2; ++ai)
#pragma unroll
                for (int m = 0; m < 4; ++m) {
                    const int row = u.pm * BM + ai * HALF + wr * 64 + m * 16 + fr; bf16_t* rp = O + (size_t)row * ldc + (u.pn & 1) * BM + colw;
#pragma unroll
                    for (int bj = 0; bj < 2; ++bj) { const float* bp = src + u.pn * BM + bj * HALF + colw; const f32x4 b0 = *(const f32x4*)bp, b1 = *(const f32x4*)(bp + 4);
                        const f32x4 v0 = acc[ai][bj][m][0] + b0, v1 = acc[ai][bj][m][1] + b1; u32x4 w;
                        w.x = pk2(gelu_tanh(v0[0]), gelu_tanh(v0[1])); w.y = pk2(gelu_tanh(v0[2]), gelu_tanh(v0[3])); w.z = pk2(gelu_tanh(v1[0]), gelu_tanh(v1[1])); w.w = pk2(gelu_tanh(v1[2]), gelu_tanh(v1[3]));
                        *(u32x4*)(rp + bj * HALF) = w; }
                    asm volatile("" ::: "memory");
                }
        }
    }
};

template <class Epi, class Sched>
__device__ __forceinline__ void gemm_phase(ldsp lds, const Gemm g, const Sched& S, const Epi& E) {
    const int tid = opaque_tid(), wid = __builtin_amdgcn_readfirstlane(tid >> 6), lane = tid & 63, wr = wid >> 2, wc = wid & 3, fr = lane & 15, fq = lane >> 4;
    const int K = g.K, nt = K / BK, lda = g.lda;
    unsigned voffA[2], voffB[2];
#pragma unroll
    for (int i = 0; i < 2; ++i) { int R, C; stage_rc(tid * 16 + i * 8192, R, C); const int Rb = Epi::PERM ? ((R & ~31) + perm32(R & 31)) : R;
        voffA[i] = (unsigned)(R * lda + C) * 2u; voffB[i] = (unsigned)(Rb * K + C) * 2u; }
    const size_t kstep = (size_t)(BK * 2);
    const size_t hstepA = (size_t)HALF * lda * 2, hstepB = (size_t)HALF * K * 2;
    const size_t tstepA = 2 * hstepA, tstepB = 2 * hstepB;
    const unsigned ldsw = (unsigned)wid * 1024u;
    const int aoff = lds_byte(wr * 64 + fr, fq * 8), boff = lds_byte(wc * 32 + fr, fq * 8);
#define PG8_SA(b, h) (((b) * 2 + (h)) * HTB)
#define PG8_SB(b, h) ((4 + (b) * 2 + (h)) * HTB)
#define PG8_STAGE(bufoff, gbase, voff) do { _Pragma("unroll") for (int _i = 0; _i < 2; ++_i) \
        __builtin_amdgcn_global_load_lds((const unsigned*)((const char*)(gbase) + (voff)[_i]), (LAS unsigned*)(lds + (bufoff) + ldsw + _i * 8192), 16, 0, 0); } while (0)
#define PG8_LDA(dst, b, h) do { _Pragma("unroll") for (int m = 0; m < 4; ++m) _Pragma("unroll") for (int k = 0; k < 2; ++k) dst[m][k] = *(const LAS bf16x8*)(lds + PG8_SA(b, h) + aoff + m * 2048 + k * 1024); } while (0)
#define PG8_LDB(dst, b, h) do { _Pragma("unroll") for (int n = 0; n < 2; ++n) _Pragma("unroll") for (int k = 0; k < 2; ++k) dst[n][k] = *(const LAS bf16x8*)(lds + PG8_SB(b, h) + boff + n * 2048 + k * 1024); } while (0)
#define PG8_MMA(ai, bj, At, Bt) do { __builtin_amdgcn_s_setprio(1); _Pragma("unroll") for (int m = 0; m < 4; ++m) _Pragma("unroll") for (int n = 0; n < 2; ++n) _Pragma("unroll") for (int k = 0; k < 2; ++k) \
        acc[ai][bj][m][n] = __builtin_amdgcn_mfma_f32_16x16x32_bf16(Bt[n][k], At[m][k], acc[ai][bj][m][n], 0, 0, 0); __builtin_amdgcn_s_setprio(0); } while (0)
#define PG8_WAIT_V(n) asm volatile("s_waitcnt vmcnt(" #n ")" ::: "memory")
#define PG8_WAIT_L(n) asm volatile("s_waitcnt lgkmcnt(" #n ")" ::: "memory")
#define PG8_BAR __builtin_amdgcn_s_barrier()
#define PG8_SCHED __builtin_amdgcn_sched_barrier(0)
    Unit cur, nxt; int ui = 0;
    if (!S.next(0, cur)) return;
    f32x4 acc[2][2][4][2];
#pragma unroll
    for (int a = 0; a < 2; ++a)
#pragma unroll
        for (int b = 0; b < 2; ++b)
#pragma unroll
            for (int m = 0; m < 4; ++m)
#pragma unroll
                for (int n = 0; n < 2; ++n) acc[a][b][m][n] = (f32x4){0.f, 0.f, 0.f, 0.f};
    bf16x8 At[4][2], B0[2][2], B1[2][2];
    const char* cA = (const char*)g.A + (size_t)cur.pm * tstepA; const char* cB = (const char*)g.Bt + (size_t)cur.pn * tstepB;
    PG8_STAGE(PG8_SB(0, 0), cB, voffB); PG8_STAGE(PG8_SB(0, 1), cB + hstepB, voffB); PG8_STAGE(PG8_SA(0, 0), cA, voffA); PG8_STAGE(PG8_SA(0, 1), cA + hstepA, voffA);
    if (wr == 1) PG8_BAR;
    PG8_WAIT_V(2); PG8_BAR;
    PG8_STAGE(PG8_SB(1, 0), cB + kstep, voffB); PG8_STAGE(PG8_SA(1, 0), cA + kstep, voffA); PG8_STAGE(PG8_SB(1, 1), cB + hstepB + kstep, voffB);
    PG8_WAIT_V(6); PG8_BAR;
    for (;;) {
        const bool has_next = S.next(ui + 1, nxt);
        const char* nA = has_next ? (const char*)g.A + (size_t)nxt.pm * tstepA : cA; const char* nB = has_next ? (const char*)g.Bt + (size_t)nxt.pn * tstepB : cB;
        for (int t = 0; t < nt; t += 2) {
            const bool last = (t == nt - 2);
            const char* a1 = cA + (size_t)(t + 1) * kstep;
            const char* a2 = last ? nA : cA + (size_t)(t + 2) * kstep; const char* b2 = last ? nB : cB + (size_t)(t + 2) * kstep;
            const char* a3 = a2 + kstep; const char* b3 = b2 + kstep;
            PG8_LDB(B0, 0, 0); PG8_LDB(B1, 0, 1); PG8_SCHED; PG8_LDA(At, 0, 0); PG8_STAGE(PG8_SA(1, 1), a1 + hstepA, voffA);
            PG8_WAIT_V(8); PG8_WAIT_L(0); PG8_BAR; PG8_MMA(0, 0, At, B0); PG8_MMA(0, 1, At, B1); PG8_BAR; PG8_SCHED;
            PG8_LDA(At, 0, 1); PG8_STAGE(PG8_SB(0, 0), b2, voffB); PG8_STAGE(PG8_SB(0, 1), b2 + hstepB, voffB); PG8_STAGE(PG8_SA(0, 0), a2, voffA);
            PG8_WAIT_V(8); PG8_WAIT_L(0); PG8_BAR; PG8_MMA(1, 0, At, B0); PG8_MMA(1, 1, At, B1); PG8_BAR; PG8_SCHED;
            PG8_LDB(B0, 1, 0); PG8_LDB(B1, 1, 1); PG8_SCHED; PG8_LDA(At, 1, 0); PG8_STAGE(PG8_SA(0, 1), a2 + hstepA, voffA);
            PG8_WAIT_V(8); PG8_WAIT_L(0); PG8_BAR; PG8_MMA(0, 0, At, B0); PG8_MMA(0, 1, At, B1); PG8_BAR; PG8_SCHED;
            PG8_LDA(At, 1, 1); PG8_STAGE(PG8_SB(1, 0), b3, voffB); PG8_STAGE(PG8_SB(1, 1), b3 + hstepB, voffB); PG8_STAGE(PG8_SA(1, 0), a3, voffA);
            PG8_WAIT_V(8); PG8_WAIT_L(0); PG8_BAR; PG8_MMA(1, 0, At, B0); PG8_MMA(1, 1, At, B1); PG8_BAR; PG8_SCHED;
        }
        if (wr == 0) PG8_BAR;
        E(acc, cur, wr, wc, fr, fq);
        if (!has_next) break;
#pragma unroll
        for (int a = 0; a < 2; ++a)
#pragma unroll
            for (int b = 0; b < 2; ++b)
#pragma unroll
                for (int m = 0; m < 4; ++m)
#pragma unroll
                    for (int n = 0; n < 2; ++n) acc[a][b][m][n] = (f32x4){0.f, 0.f, 0.f, 0.f};
        cur = nxt; cA = nA; cB = nB; ++ui;
        if (wr == 1) PG8_BAR;
    }
    PG8_WAIT_V(0);
    PG8_BAR;
#undef PG8_SA
#undef PG8_SB
#undef PG8_STAGE
#undef PG8_LDA
#undef PG8_LDB
#undef PG8_MMA
#undef PG8_WAIT_V
#undef PG8_WAIT_L
#undef PG8_BAR
#undef PG8_SCHED
}
}

struct Params {
    const float* x; const float* ln_g; const float* ln_b;
    const float* ffn1_in; const float* ffn1_out; const float* ffn2_in; const float* ffn2_out;
    const float* ret_in; const float* gn_g; const float* gn_b; const float* ret_out;
    const float* kv_w; const float* cmp_pos; const float* cmp_w1; const float* cmp_b1; const float* cmp_w2;
    const float* nsa_q; const float* nsa_out;
    float* out; unsigned char* ws;
    int ph_lo, ph_hi;
};

__device__ __forceinline__ int dest_row(int n, int mode) { if (mode == 0) return n; const int isu = n >= FF ? 1 : 0, j = n - isu * FF; return (j >> 7) * 256 + isu * 128 + (j & 127); }
__device__ __forceinline__ void transpose_item(const float* W, int K, int N, bf16_t* WT, int mode, LAS float* scr, int item, int nblk, int lane) {
    const int kb = item / nblk, nb = item % nblk, k0 = 64 * kb, n0 = 64 * nb;
    const int nq = 4 * (lane & 15), kr = lane >> 4;
    const bool inb = (n0 + nq) < N;
    f32x4 v[16];
#pragma unroll
    for (int i = 0; i < 16; ++i) v[i] = inb ? *(const f32x4*)(W + (size_t)(k0 + 4 * i + kr) * N + n0 + nq) : (f32x4){0.f, 0.f, 0.f, 0.f};
#pragma unroll
    for (int i = 0; i < 16; ++i) { LAS float* d = scr + (4 * i + kr) * 65 + nq; d[0] = v[i][0]; d[1] = v[i][1]; d[2] = v[i][2]; d[3] = v[i][3]; }
    asm volatile("s_waitcnt lgkmcnt(0)" ::: "memory");
    const int c = lane & 7;
#pragma unroll
    for (int j = 0; j < 8; ++j) { const int n = (lane >> 3) + 8 * j; const LAS float* sp = scr + (8 * c) * 65 + n;
        u32x4 o; o.x = pk2(sp[0 * 65], sp[1 * 65]); o.y = pk2(sp[2 * 65], sp[3 * 65]); o.z = pk2(sp[4 * 65], sp[5 * 65]); o.w = pk2(sp[6 * 65], sp[7 * 65]);
        *(u32x4*)(WT + (size_t)dest_row(n0 + n, mode) * K + k0 + 8 * c) = o; }
    asm volatile("s_waitcnt lgkmcnt(0)" ::: "memory");
}
__device__ __forceinline__ void convert_part(ldsp lds, const float* W, int K, int N, int Npad, int mode, bf16_t* WT, int gw, int NGW) {
    const int tid = opaque_tid(), lane = tid & 63, wave = rfl(tid >> 6);
    LAS float* scr = (LAS float*)(lds + wave * 16640);
    const int nblk = Npad / 64, nitems = (K / 64) * nblk;
    for (int it = gw; it < nitems; it += NGW) transpose_item(W, K, N, WT, mode, scr, it, nblk, lane);
}
__device__ __forceinline__ void convert_one(ldsp lds, const float* W, int K, int N, int Npad, int mode, bf16_t* WT) {
    const int wave = rfl((int)threadIdx.x >> 6);
    convert_part(lds, W, K, N, Npad, mode, WT, blockIdx.x * 8 + wave, gridDim.x * 8);
}

__device__ __forceinline__ void ln_phase(const float* Y, float* X, bf16_t* Xb, const float* g, const float* b) {
    const int tid = opaque_tid(), lane = tid & 63, wave = rfl(tid >> 6);
    const int gw = blockIdx.x * 8 + wave, NGW = gridDim.x * 8;
    f32x4 gv[8], bv[8];
#pragma unroll
    for (int j = 0; j < 8; ++j) { gv[j] = *(const f32x4*)(g + 4 * lane + 256 * j); bv[j] = *(const f32x4*)(b + 4 * lane + 256 * j); }
    for (int m = gw; m < M; m += NGW) {
        const f32x4* yr = (const f32x4*)(Y + (size_t)m * D) + lane; f32x4 v[8]; float s = 0.f;
#pragma unroll
        for (int j = 0; j < 8; ++j) { v[j] = yr[64 * j]; s += (v[j][0] + v[j][1]) + (v[j][2] + v[j][3]); }
        const float mean = wave_sum(s) * (1.f / D); float s2 = 0.f;
#pragma unroll
        for (int j = 0; j < 8; ++j) { v[j] = v[j] - mean; s2 += (v[j][0] * v[j][0] + v[j][1] * v[j][1]) + (v[j][2] * v[j][2] + v[j][3] * v[j][3]); }
        const float rstd = 1.f / sqrtf(wave_sum(s2) * (1.f / D) + LN_EPS);
        f32x4* xr = (f32x4*)(X + (size_t)m * D) + lane; u32x2* br = (u32x2*)(Xb + (size_t)m * D) + lane;
#pragma unroll
        for (int j = 0; j < 8; ++j) { const f32x4 o = v[j] * rstd * gv[j] + bv[j]; xr[64 * j] = o; u32x2 w; w.x = pk2(o[0], o[1]); w.y = pk2(o[2], o[3]); br[64 * j] = w; }
    }
}

__device__ __forceinline__ void ret_phase(ldsp lds, bf16_t* R) {
    const int tid = opaque_tid(), lane = tid & 63, w = rfl(tid >> 6);
    constexpr int QS = 528, VS = 272, SS = 144;
    ldsp Qs = lds, Ks = lds + 64 * QS, Vs = lds + 128 * QS, Ss = lds + 128 * QS + 64 * VS;
    const int G = gridDim.x, vcu = vcu_of();
    for (int u = vcu; u < 256; u += G) {
        const int b = u >> 5, h = (u >> 2) & 7, vs = u & 3;
        const float l2g = __builtin_log2f(1.f - ex2(-5.f - (float)h));
        const float gC = ex2(l2g * (float)RC);
        f32x4 St[16];
#pragma unroll
        for (int k = 0; k < 16; ++k) St[k] = (f32x4){0.f, 0.f, 0.f, 0.f};
        bf16_t* Rb = R + (size_t)b * T * RETC;
        const int qc = h * 256, kc = 2048 + h * 256, vc = 4096 + h * 512 + vs * 128, vbase = 16 * w;
        u32x4 pq[4], pk[4], pv[2];
#define RET_GLOAD(cc) do { const bf16_t* Rn_ = Rb + (size_t)(RC * (cc)) * RETC; \
            _Pragma("unroll") for (int i = 0; i < 4; ++i) { const int p = tid + 512 * i, r = p >> 5, ch = p & 31; pq[i] = *(const u32x4*)(Rn_ + (size_t)r * RETC + qc + ch * 8); pk[i] = *(const u32x4*)(Rn_ + (size_t)r * RETC + kc + ch * 8); } \
            _Pragma("unroll") for (int i = 0; i < 2; ++i) { const int p = tid + 512 * i, r = p >> 4, ch = p & 15; pv[i] = *(const u32x4*)(Rn_ + (size_t)r * RETC + vc + ch * 8); } } while (0)
        RET_GLOAD(0);
        for (int c = 0; c < T / RC; ++c) {
            bf16_t* Rc = Rb + (size_t)(RC * c) * RETC;
            __syncthreads();
#pragma unroll
            for (int i = 0; i < 4; ++i) { const int p = tid + 512 * i, r = p >> 5, ch = p & 31; *(LAS u32x4*)(Qs + r * QS + ch * 16) = pq[i]; *(LAS u32x4*)(Ks + r * QS + ch * 16) = pk[i]; }
#pragma unroll
            for (int i = 0; i < 2; ++i) { const int p = tid + 512 * i, r = p >> 4, ch = p & 15; *(LAS u32x4*)(Vs + r * VS + ch * 16) = pv[i]; }
            __syncthreads();
            if (c + 1 < T / RC) RET_GLOAD(c + 1);
            int lane_o = lane; asm volatile("" : "+v"(lane_o));
            const int li = lane_o & 15, g4 = lane_o >> 4, tq = li >> 2, tp = li & 3;
            {
                const int nt = w >> 1;
#pragma unroll
                for (int mt2 = 0; mt2 < 2; ++mt2) { const int mt = 2 * (w & 1) + mt2; f32x4 acc = (f32x4){0.f, 0.f, 0.f, 0.f};
                    if (mt <= nt) {
#pragma unroll
                        for (int ks = 0; ks < 8; ++ks) { const bf16x8 a = *(const LAS bf16x8*)(Qs + (16 * nt + li) * QS + (32 * ks + 8 * g4) * 2), bb = *(const LAS bf16x8*)(Ks + (16 * mt + li) * QS + (32 * ks + 8 * g4) * 2); acc = mfma16(a, bb, acc); }
                    }
#pragma unroll
                    for (int i = 0; i < 4; ++i) { const int n = 16 * nt + 4 * g4 + i, mm = 16 * mt + li; const float val = (mm <= n) ? acc[i] * ex2(l2g * (float)(n - (RC - 1))) : 0.f; *(LAS bf16_t*)(Ss + n * SS + mm * 2) = (bf16_t)f2bf(val); }
                }
            }
            __syncthreads();
            bf16x8 vf[2];
#pragma unroll
            for (int ms = 0; ms < 2; ++ms) { const s16x4 lo = trrd(Vs + (32 * ms + 8 * g4 + tq) * VS + (vbase + 4 * tp) * 2), hi = trrd(Vs + (32 * ms + 8 * g4 + 4 + tq) * VS + (vbase + 4 * tp) * 2); vf[ms] = cat8(lo, hi); }
            bf16x8 sb[8];
#pragma unroll
            for (int ks = 0; ks < 8; ++ks) { u32x4 wv; wv.x = pk2(St[2 * ks][0], St[2 * ks][1]); wv.y = pk2(St[2 * ks][2], St[2 * ks][3]); wv.z = pk2(St[2 * ks + 1][0], St[2 * ks + 1][1]); wv.w = pk2(St[2 * ks + 1][2], St[2 * ks + 1][3]); sb[ks] = __builtin_bit_cast(bf16x8, wv); }
#pragma unroll
            for (int nt = 0; nt < 4; ++nt) {
                f32x4 o = (f32x4){0.f, 0.f, 0.f, 0.f}, cr = (f32x4){0.f, 0.f, 0.f, 0.f};
#pragma unroll
                for (int ms = 0; ms < 2; ++ms) if (32 * ms <= 16 * nt + 15) { const bf16x8 a = *(const LAS bf16x8*)(Ss + (16 * nt + li) * SS + (32 * ms + 8 * g4) * 2); o = mfma16(a, vf[ms], o); }
#pragma unroll
                for (int ks = 0; ks < 8; ++ks) { const s16x4 lo = *(const LAS s16x4*)(Qs + (16 * nt + li) * QS + (32 * ks + 4 * g4) * 2), hi = *(const LAS s16x4*)(Qs + (16 * nt + li) * QS + (32 * ks + 16 + 4 * g4) * 2); cr = mfma16(cat8(lo, hi), sb[ks], cr); }
#pragma unroll
                for (int i = 0; i < 4; ++i) { const int n = 16 * nt + 4 * g4 + i; const float val = o[i] + ex2(l2g * (float)(n + 1)) * cr[i]; Rc[(size_t)n * RETC + vc + vbase + li] = (bf16_t)f2bf(val); }
                __builtin_amdgcn_sched_barrier(0);
            }
#pragma unroll
            for (int kt = 0; kt < 16; ++kt) { St[kt] = St[kt] * gC;
#pragma unroll
                for (int ms = 0; ms < 2; ++ms) { const s16x4 lo = trrd(Ks + (32 * ms + 8 * g4 + tq) * QS + (16 * kt + 4 * tp) * 2), hi = trrd(Ks + (32 * ms + 8 * g4 + 4 + tq) * QS + (16 * kt + 4 * tp) * 2); St[kt] = mfma16(cat8(lo, hi), vf[ms], St[kt]); }
                if (kt & 1) __builtin_amdgcn_sched_barrier(0);
            }
        }
    }
#undef RET_GLOAD
    __syncthreads();
}

__device__ __forceinline__ void gn_phase(bf16_t* R, const float* gg, const float* gb) {
    const int tid = opaque_tid(), lane = tid & 63, wave = rfl(tid >> 6);
    const int gw = blockIdx.x * 8 + wave, NGW = gridDim.x * 8;
    for (int it = gw; it < M * 8; it += NGW) {
        const int row = it >> 3, h = it & 7;
        bf16_t* op = R + (size_t)row * RETC + 4096 + h * 512 + 8 * lane; bf16_t* gp = op + 4096;
        const u32x4 ov = *(const u32x4*)op, gv = *(const u32x4*)gp;
        float o[8] = {bflo(ov.x), bfhi(ov.x), bflo(ov.y), bfhi(ov.y), bflo(ov.z), bfhi(ov.z), bflo(ov.w), bfhi(ov.w)};
        float gt[8] = {bflo(gv.x), bfhi(gv.x), bflo(gv.y), bfhi(gv.y), bflo(gv.z), bfhi(gv.z), bflo(gv.w), bfhi(gv.w)};
        float s = 0.f;
#pragma unroll
        for (int i = 0; i < 8; ++i) s += o[i];
        const float mean = wave_sum(s) * (1.f / 512.f); float s2 = 0.f;
#pragma unroll
        for (int i = 0; i < 8; ++i) { o[i] -= mean; s2 += o[i] * o[i]; }
        const float rstd = 1.f / sqrtf(wave_sum(s2) * (1.f / 512.f) + LN_EPS);
        const f32x4 g0 = *(const f32x4*)(gg + h * 512 + 8 * lane), g1 = *(const f32x4*)(gg + h * 512 + 8 * lane + 4), b0 = *(const f32x4*)(gb + h * 512 + 8 * lane), b1 = *(const f32x4*)(gb + h * 512 + 8 * lane + 4);
        float y[8];
#pragma unroll
        for (int i = 0; i < 8; ++i) { const float gi = i < 4 ? g0[i & 3] : g1[i & 3], bi = i < 4 ? b0[i & 3] : b1[i & 3]; y[i] = siluf(gt[i]) * (o[i] * rstd * gi + bi); }
        u32x4 w; w.x = pk2(y[0], y[1]); w.y = pk2(y[2], y[3]); w.z = pk2(y[4], y[5]); w.w = pk2(y[6], y[7]); *(u32x4*)gp = w;
    }
}

__device__ __forceinline__ void cmp_gather_phase(const bf16_t* KV, const float* cmp_pos, bf16_t* A) {
    const size_t gt = (size_t)blockIdx.x * 512 + threadIdx.x, NT = (size_t)gridDim.x * 512;
    for (size_t p = gt; p < (size_t)2 * 4096 * 512; p += NT) {
        const int dch = (int)(p & 15), l = (int)((p >> 4) & 31), Rr = (int)((p >> 9) & 4095), c = (int)(p >> 21);
        const int n = Rr & 127, bg = Rr >> 7, b = bg >> 2, g = bg & 3;
        u32x4 w = (u32x4){0u, 0u, 0u, 0u};
        if (n < 127) {
            const u32x4 kv = *(const u32x4*)(KV + (size_t)(b * T + 16 * n + l) * KVC + c * 512 + g * 128 + dch * 8);
            const float* pp = cmp_pos + (c * 32 + l) * 128 + dch * 8; const f32x4 p0 = *(const f32x4*)pp, p1 = *(const f32x4*)(pp + 4);
            w.x = pk2(bflo(kv.x) + p0[0], bfhi(kv.x) + p0[1]); w.y = pk2(bflo(kv.y) + p0[2], bfhi(kv.y) + p0[3]); w.z = pk2(bflo(kv.z) + p1[0], bfhi(kv.z) + p1[1]); w.w = pk2(bflo(kv.w) + p1[2], bfhi(kv.w) + p1[3]);
        }
        *(u32x4*)(A + ((size_t)c * 4096 + Rr) * 4096 + l * 128 + dch * 8) = w;
    }
}
__device__ __forceinline__ void cmp2_phase(const bf16_t* Hc, const float* W2, const float* ncos, const float* nsin, bf16_t* Kc, bf16_t* Vc) {
    const int gt = blockIdx.x * 512 + threadIdx.x, NT = gridDim.x * 512;
    for (int p = gt; p < 2 * 4096 * 16; p += NT) {
        const int dq = p & 15, Rr = (p >> 4) & 4095, c = p >> 16;
        const bf16_t* hr = Hc + ((size_t)c * 4096 + Rr) * 512; const float* w2 = W2 + (size_t)c * 512 * 128 + dq;
        float acc[8];
#pragma unroll
        for (int i = 0; i < 8; ++i) acc[i] = 0.f;
        for (int e0 = 0; e0 < 512; e0 += 8) {
            const u32x4 hv = *(const u32x4*)(hr + e0);
            const float hh[8] = {bflo(hv.x), bfhi(hv.x), bflo(hv.y), bfhi(hv.y), bflo(hv.z), bfhi(hv.z), bflo(hv.w), bfhi(hv.w)};
#pragma unroll
            for (int e = 0; e < 8; ++e)
#pragma unroll
                for (int i = 0; i < 8; ++i) acc[i] += hh[e] * w2[(size_t)(e0 + e) * 128 + 16 * i];
        }
        const int n = Rr & 127;
        if (c == 0) { const int pos = (16 * n + 31) & (T - 1); const float cs = ncos[pos * 16 + dq], sn = nsin[pos * 16 + dq]; const float x1 = acc[0], x2 = acc[1]; acc[0] = x1 * cs - x2 * sn; acc[1] = x2 * cs + x1 * sn; }
        bf16_t* o = (c == 0 ? Kc : Vc) + (size_t)Rr * 128 + dq;
#pragma unroll
        for (int i = 0; i < 8; ++i) o[16 * i] = (bf16_t)f2bf(acc[i]);
    }
}

constexpr int KSTR = 272;
__device__ __forceinline__ void load_tile64(ldsp dst, const bf16_t* src, int ld, int tid) {
#pragma unroll
    for (int i = 0; i < 2; ++i) { const int p = tid + 512 * i, r = p >> 4, ch = p & 15; const u32x4 v = *(const u32x4*)(src + (size_t)r * ld + ch * 8); *(LAS u32x4*)(dst + r * KSTR + ch * 16) = v; }
}
struct TileRegs { u32x4 k0, k1, v0, v1; };
__device__ __forceinline__ void tile_gload(TileRegs& r, const bf16_t* kp, const bf16_t* vp, int ld, int tid) {
    const int p0 = tid, p1 = tid + 512;
    r.k0 = *(const u32x4*)(kp + (size_t)(p0 >> 4) * ld + (p0 & 15) * 8); r.k1 = *(const u32x4*)(kp + (size_t)(p1 >> 4) * ld + (p1 & 15) * 8);
    r.v0 = *(const u32x4*)(vp + (size_t)(p0 >> 4) * ld + (p0 & 15) * 8); r.v1 = *(const u32x4*)(vp + (size_t)(p1 >> 4) * ld + (p1 & 15) * 8);
}
__device__ __forceinline__ void tile_lstore(ldsp Kt, ldsp Vt, const TileRegs& r, int tid) {
    const int p0 = tid, p1 = tid + 512;
    *(LAS u32x4*)(Kt + (p0 >> 4) * KSTR + (p0 & 15) * 16) = r.k0; *(LAS u32x4*)(Kt + (p1 >> 4) * KSTR + (p1 & 15) * 16) = r.k1;
    *(LAS u32x4*)(Vt + (p0 >> 4) * KSTR + (p0 & 15) * 16) = r.v0; *(LAS u32x4*)(Vt + (p1 >> 4) * KSTR + (p1 & 15) * 16) = r.v1;
}
__device__ __forceinline__ void attn_step(ldsp Kt, ldsp Vt, const bf16x8 (&qf)[8], float& mrow, float& lrow, f32x16 (&Oc)[4], int kp0, int t, int lo, bool en, int ql, int h5, int lane) {
    f32x16 s[2];
#pragma unroll
    for (int kb = 0; kb < 2; ++kb) { s[kb] = (f32x16){};
#pragma unroll
        for (int ks = 0; ks < 8; ++ks) { const bf16x8 a = *(const LAS bf16x8*)(Kt + (32 * kb + ql) * KSTR + (16 * ks + 8 * h5) * 2); s[kb] = mfma32(a, qf[ks], s[kb]); }
        __builtin_amdgcn_sched_barrier(0); }
    float mx = -1e30f;
    const int hiL = t - kp0 - 4 * h5, loL = lo - kp0 - 4 * h5;
#pragma unroll
    for (int kb = 0; kb < 2; ++kb)
#pragma unroll
        for (int r = 0; r < 16; ++r) { const int cr = 32 * kb + (r & 3) + 8 * (r >> 2); const bool v = en && cr <= hiL && cr > loL; s[kb][r] = v ? s[kb][r] : -1e30f; mx = fmaxf(mx, s[kb][r]); }
    mx = fmaxf(mx, __shfl_xor(mx, 32));
    const float mnew = fmaxf(mrow, mx), al = ex2(mrow - mnew); mrow = mnew;
    float ps = 0.f;
#pragma unroll
    for (int kb = 0; kb < 2; ++kb)
#pragma unroll
        for (int r = 0; r < 16; ++r) { const float p = s[kb][r] > -1e29f ? ex2(s[kb][r] - mnew) : 0.f; s[kb][r] = p; ps += p; }
    lrow = lrow * al + ps;
#pragma unroll
    for (int d = 0; d < 4; ++d) Oc[d] = Oc[d] * al;
    const int li = lane & 15, tq = li >> 2, tp = li & 3, gi = (lane >> 4) & 1;
#pragma unroll
    for (int kb = 0; kb < 2; ++kb)
#pragma unroll
        for (int sx = 0; sx < 2; ++sx) {
            u32x4 pw; pw.x = pk2(s[kb][8 * sx + 0], s[kb][8 * sx + 1]); pw.y = pk2(s[kb][8 * sx + 2], s[kb][8 * sx + 3]); pw.z = pk2(s[kb][8 * sx + 4], s[kb][8 * sx + 5]); pw.w = pk2(s[kb][8 * sx + 6], s[kb][8 * sx + 7]);
            const bf16x8 pf = __builtin_bit_cast(bf16x8, pw);
            const int kbase = 32 * kb + 16 * sx + 4 * h5;
#pragma unroll
            for (int d = 0; d < 4; ++d) { const int cb = 32 * d + 16 * gi + 4 * tp;
                const s16x4 lo4 = trrd(Vt + (kbase + tq) * KSTR + cb * 2), hi4 = trrd(Vt + (kbase + 8 + tq) * KSTR + cb * 2);
                Oc[d] = mfma32(cat8(lo4, hi4), pf, Oc[d]); }
            __builtin_amdgcn_sched_barrier(0);
        }
}

__device__ __forceinline__ void nsa_phase(ldsp lds, const bf16_t* Qn, const bf16_t* KV, const bf16_t* Kc, const bf16_t* Vc, bf16_t* O) {
    const int tid = opaque_tid(), lane = tid & 63, w = rfl(tid >> 6), ql = lane & 31, h5 = lane >> 5;
    ldsp Kt = lds, Vt = lds + 128 * KSTR; LAS float* PS = (LAS float*)(lds + 256 * KSTR); LAS unsigned* SEL = (LAS unsigned*)(lds + 256 * KSTR + 32768); LAS unsigned* UNI = SEL + 64;
    const int G = gridDim.x, vcu = vcu_of();
    const int hh = w >> 1, th = w & 1, tqi = 32 * th + ql;
    for (int uu = vcu; uu < 1024; uu += G) {
        const int v8 = uu % 256, rnd = uu / 256; const int bg = v8 >> 3, s8 = v8 & 7; const int qb = rnd == 0 ? s8 : rnd == 1 ? 15 - s8 : rnd == 2 ? 16 + s8 : 31 - s8;
        const int b = bg >> 2, g = bg & 3;
        const int t = 64 * qb + tqi; const size_t row = (size_t)b * T + t;
        const bf16_t* qp = Qn + row * NQC + (4 * g + hh) * 128;
        bf16x8 qf[8];
#pragma unroll
        for (int ks = 0; ks < 8; ++ks) qf[ks] = *(const bf16x8*)(qp + 16 * ks + 8 * h5);
        float gate[3];
#pragma unroll
        for (int i = 0; i < 3; ++i) gate[i] = sigmf(bf2f(Qn[row * NQC + 2048 + (4 * g + hh) * 3 + i]));
        unsigned Oa[4][8];
        __syncthreads();
        load_tile64(Kt, Kc + (size_t)bg * 128 * 128, 128, tid); load_tile64(Kt + 64 * KSTR, Kc + (size_t)bg * 128 * 128 + 64 * 128, 128, tid);
        load_tile64(Vt, Vc + (size_t)bg * 128 * 128, 128, tid); load_tile64(Vt + 64 * KSTR, Vc + (size_t)bg * 128 * 128 + 64 * 128, 128, tid);
        if (tid == 0) UNI[0] = 0u;
        __syncthreads();
        {
            f32x16 s[4]; float mx = -1e30f;
            const int nlim = min(126, (t - 31) >> 4) - 4 * h5;
#pragma unroll
            for (int kb = 0; kb < 4; ++kb) { s[kb] = (f32x16){};
#pragma unroll
                for (int ks = 0; ks < 8; ++ks) { const bf16x8 a = *(const LAS bf16x8*)(Kt + (32 * kb + ql) * KSTR + (16 * ks + 8 * h5) * 2); s[kb] = mfma32(a, qf[ks], s[kb]); }
#pragma unroll
                for (int r = 0; r < 16; ++r) { const int cn = 32 * kb + (r & 3) + 8 * (r >> 2); const bool v = cn <= nlim; s[kb][r] = v ? s[kb][r] : -1e30f; mx = fmaxf(mx, s[kb][r]); } }
            mx = fmaxf(mx, __shfl_xor(mx, 32));
            float ps = 0.f;
#pragma unroll
            for (int kb = 0; kb < 4; ++kb)
#pragma unroll
                for (int r = 0; r < 16; ++r) { const float p = s[kb][r] > -1e29f ? ex2(s[kb][r] - mx) : 0.f; s[kb][r] = p; ps += p; }
            ps += __shfl_xor(ps, 32);
            const float inv = ps > 0.f ? 1.f / ps : 0.f;
            float Gs[16], Es[16];
#pragma unroll
            for (int kb = 0; kb < 4; ++kb)
#pragma unroll
                for (int rr = 0; rr < 4; ++rr) { float a0 = s[kb][4 * rr] * inv, a1 = s[kb][4 * rr + 1] * inv, a2 = s[kb][4 * rr + 2] * inv, a3 = s[kb][4 * rr + 3] * inv;
                    s[kb][4 * rr] = a0; s[kb][4 * rr + 1] = a1; s[kb][4 * rr + 2] = a2; s[kb][4 * rr + 3] = a3; Gs[kb * 4 + rr] = (a0 + a1) + (a2 + a3); Es[kb * 4 + rr] = a3; }
            float prevE = 0.f;
#pragma unroll
            for (int idx = 0; idx < 16; ++idx) { const float ep = __shfl_xor(Es[idx], 32); const float val = Gs[idx] + (h5 ? ep : prevE); prevE = ep;
                const int j = 8 * (idx >> 2) + 2 * (idx & 3) + h5; PS[(hh * 64 + tqi) * 32 + j] = val; }
            f32x16 Oc[4];
#pragma unroll
            for (int d = 0; d < 4; ++d) Oc[d] = (f32x16){};
            const int li = lane & 15, tq = li >> 2, tp = li & 3, gi = (lane >> 4) & 1;
#pragma unroll
            for (int kb = 0; kb < 4; ++kb)
#pragma unroll
                for (int sx = 0; sx < 2; ++sx) {
                    u32x4 pw; pw.x = pk2(s[kb][8 * sx + 0], s[kb][8 * sx + 1]); pw.y = pk2(s[kb][8 * sx + 2], s[kb][8 * sx + 3]); pw.z = pk2(s[kb][8 * sx + 4], s[kb][8 * sx + 5]); pw.w = pk2(s[kb][8 * sx + 6], s[kb][8 * sx + 7]);
                    const bf16x8 pf = __builtin_bit_cast(bf16x8, pw); const int kbase = 32 * kb + 16 * sx + 4 * h5;
#pragma unroll
                    for (int d = 0; d < 4; ++d) { const int cb = 32 * d + 16 * gi + 4 * tp;
                        const s16x4 lo4 = trrd(Vt + (kbase + tq) * KSTR + cb * 2), hi4 = trrd(Vt + (kbase + 8 + tq) * KSTR + cb * 2);
                        Oc[d] = mfma32(cat8(lo4, hi4), pf, Oc[d]); }
                    __builtin_amdgcn_sched_barrier(0);
                }
#pragma unroll
            for (int d = 0; d < 4; ++d)
#pragma unroll
                for (int r = 0; r < 8; ++r) Oa[d][r] = pk2(Oc[d][2 * r] * gate[0], Oc[d][2 * r + 1] * gate[0]);
        }
        __syncthreads();
        if (tid < 64) {
            float sc[32];
#pragma unroll
            for (int j = 0; j < 32; ++j) sc[j] = (PS[(0 * 64 + tid) * 32 + j] + PS[(1 * 64 + tid) * 32 + j]) + (PS[(2 * 64 + tid) * 32 + j] + PS[(3 * 64 + tid) * 32 + j]);
            const int cur = qb; unsigned sel = 1u | (1u << cur) | (cur > 0 ? (1u << (cur - 1)) : 0u);
            const int need = 8 - __builtin_popcount(sel);
#pragma unroll
            for (int it = 0; it < 5; ++it) if (it < need) { float best = -1.f; int bj = -1;
#pragma unroll
                for (int j = 1; j < 32; ++j) { const bool ok = (j <= cur - 2) && !((sel >> j) & 1u); if (ok && sc[j] > best) { best = sc[j]; bj = j; } }
                if (bj >= 0) sel |= 1u << bj; }
            SEL[tid] = sel; atomicOr((unsigned*)UNI, sel);
        }
        __syncthreads();
        const unsigned mysel = SEL[tqi], uni = UNI[0];
        {
            float mrow = -1e30f, lrow = 0.f; f32x16 Oc[4];
#pragma unroll
            for (int d = 0; d < 4; ++d) Oc[d] = (f32x16){};
            const bf16_t* kvb = KV + (size_t)b * T * KVC + g * 128;
            unsigned rem = uni & (0xffffffffu >> (31 - qb));
            int j = __builtin_ctz(rem); rem &= rem - 1u;
            TileRegs tr; tile_gload(tr, kvb + (size_t)(64 * j) * KVC + 2 * 512, kvb + (size_t)(64 * j) * KVC + 3 * 512, KVC, tid);
            for (;;) {
                __syncthreads();
                tile_lstore(Kt, Vt, tr, tid);
                __syncthreads();
                int jn = -1;
                if (rem) { jn = __builtin_ctz(rem); rem &= rem - 1u; tile_gload(tr, kvb + (size_t)(64 * jn) * KVC + 2 * 512, kvb + (size_t)(64 * jn) * KVC + 3 * 512, KVC, tid); }
                attn_step(Kt, Vt, qf, mrow, lrow, Oc, 64 * j, t, -1, ((mysel >> j) & 1u) != 0u, ql, h5, lane);
                if (jn < 0) break;
                j = jn;
            }
            lrow += __shfl_xor(lrow, 32); const float sc = gate[1] / lrow;
#pragma unroll
            for (int d = 0; d < 4; ++d)
#pragma unroll
                for (int r = 0; r < 8; ++r) Oa[d][r] = pk2(bflo(Oa[d][r]) + Oc[d][2 * r] * sc, bfhi(Oa[d][r]) + Oc[d][2 * r + 1] * sc);
        }
        {
            float mrow = -1e30f, lrow = 0.f; f32x16 Oc[4];
#pragma unroll
            for (int d = 0; d < 4; ++d) Oc[d] = (f32x16){};
            const bf16_t* kvb = KV + (size_t)b * T * KVC + g * 128;
            int j = (qb > 8 ? qb - 8 : 0);
            TileRegs tr; tile_gload(tr, kvb + (size_t)(64 * j) * KVC + 4 * 512, kvb + (size_t)(64 * j) * KVC + 5 * 512, KVC, tid);
            for (;;) {
                __syncthreads();
                tile_lstore(Kt, Vt, tr, tid);
                __syncthreads();
                const int jn = j + 1;
                if (jn <= qb) tile_gload(tr, kvb + (size_t)(64 * jn) * KVC + 4 * 512, kvb + (size_t)(64 * jn) * KVC + 5 * 512, KVC, tid);
                attn_step(Kt, Vt, qf, mrow, lrow, Oc, 64 * j, t, t - 512, true, ql, h5, lane);
                if (jn > qb) break;
                j = jn;
            }
            lrow += __shfl_xor(lrow, 32); const float sc = gate[2] / lrow;
            bf16_t* op = O + row * D + (4 * g + hh) * 128 + 4 * h5;
#pragma unroll
            for (int d = 0; d < 4; ++d)
#pragma unroll
                for (int rr = 0; rr < 4; ++rr) { u32x2 wv;
                    wv.x = pk2(bflo(Oa[d][2 * rr]) + Oc[d][4 * rr] * sc, bfhi(Oa[d][2 * rr]) + Oc[d][4 * rr + 1] * sc);
                    wv.y = pk2(bflo(Oa[d][2 * rr + 1]) + Oc[d][4 * rr + 2] * sc, bfhi(Oa[d][2 * rr + 1]) + Oc[d][4 * rr + 3] * sc);
                    *(u32x2*)(op + 32 * d + 8 * rr) = wv; }
        }
    }
    __syncthreads();
}

#ifndef COSF
#define COSF cosf
#define SINF sinf
#endif
#ifndef GMASK
#define GMASK 0xffff
#endif
constexpr int NPHASE = 26;
typedef const __attribute__((address_space(4))) Params* cparams_t;
__device__ __forceinline__ cparams_t kparams() { const __attribute__((address_space(4))) void* q = (const __attribute__((address_space(4))) void*)__builtin_amdgcn_kernarg_segment_ptr(); asm volatile("" : "+s"(q)); return (cparams_t)q; }
#define PHASE_BEGIN if (lo <= ph && ph < hi) { cparams_t pp = kparams(); unsigned char* ws = pp->ws; bf16_t* Xb = (bf16_t*)(ws + WS_XB); bf16_t* KVb = (bf16_t*)(ws + WS_KV); bf16_t* R = (bf16_t*)(ws + WS_R); bf16_t* Hb = (bf16_t*)(ws + WS_R + R_H); \
    float* rcos = (float*)(ws + WS_ROPE_R); float* rsin = rcos + 2048 * 128; float* ncos = (float*)(ws + WS_ROPE_N); float* nsin = ncos + 2048 * 16; (void)Xb; (void)KVb; (void)R; (void)Hb; (void)rcos; (void)rsin; (void)ncos; (void)nsin;
#define PHASE_END } if (lo <= ph && ph + 1 < hi) grid.sync(); ++ph;

template <int layer> __device__ __forceinline__ void run_layer(ldsp lds, cg::grid_group& grid, const int lo, const int hi, int& ph, const int G) {
        PHASE_BEGIN
            pg8::Gemm g{Xb, (const bf16_t*)(ws + W_FFN1_IN), M, 2 * FF, D, D}; pg8::StaticOrder S; S.init(M, 2 * FF, G, (int)blockIdx.x);
            pg8::Epi<pg8::EPI_SWIGLU> E{Hb, nullptr, FF, 0.f, 0.f, nullptr, nullptr};
            if (GMASK & (1 << 0)) pg8::gemm_phase(lds, g, S, E);
        PHASE_END
        PHASE_BEGIN
            pg8::Gemm g{Hb, (const bf16_t*)(ws + W_FFN1_OUT), M, D, FF, FF}; pg8::StaticOrder S; S.init(M, D, G, (int)blockIdx.x);
            pg8::Epi<pg8::EPI_RESID> E{pp->out, layer == 0 ? pp->x : pp->out, D, ALPHA, 0.5f, nullptr, nullptr};
            if (GMASK & (1 << 1)) pg8::gemm_phase(lds, g, S, E);
        PHASE_END
        PHASE_BEGIN
            ln_phase(pp->out, pp->out, Xb, pp->ln_g + layer * 3 * D, pp->ln_b + layer * 3 * D);
        PHASE_END
        if constexpr (layer == 0) {
            PHASE_BEGIN
                pg8::Gemm g{Xb, (const bf16_t*)(ws + W_RET_IN), M, RETC, D, D}; pg8::StaticOrder S; S.init(M, RETC, G, (int)blockIdx.x);
                pg8::Epi<pg8::EPI_RET> E{R, nullptr, RETC, 0.f, 0.f, rcos, rsin};
                if (GMASK & (1 << 2)) pg8::gemm_phase(lds, g, S, E);
            PHASE_END
            PHASE_BEGIN
#ifndef SKIP_RET
                ret_phase(lds, R);
#endif
            PHASE_END
            PHASE_BEGIN
                gn_phase(R, pp->gn_g, pp->gn_b);
            PHASE_END
            PHASE_BEGIN
                pg8::Gemm g{R + 8192, (const bf16_t*)(ws + W_RET_OUT), M, D, 4096, RETC}; pg8::StaticOrder S; S.init(M, D, G, (int)blockIdx.x);
                pg8::Epi<pg8::EPI_RESID> E{pp->out, pp->out, D, ALPHA, 1.0f, nullptr, nullptr};
                if (GMASK & (1 << 3)) pg8::gemm_phase(lds, g, S, E);
            PHASE_END
        } else {
            PHASE_BEGIN
                pg8::Gemm g{Xb, (const bf16_t*)(ws + W_NSA_Q), M, NQC, D, D}; pg8::StaticOrder S; S.init(M, NQC, G, (int)blockIdx.x);
                pg8::Epi<pg8::EPI_NSAQ> E{(bf16_t*)(ws + WS_R + R_QN), nullptr, NQC, QSCALE, 0.f, ncos, nsin};
                if (GMASK & (1 << 4)) pg8::gemm_phase(lds, g, S, E);
            PHASE_END
            PHASE_BEGIN
#ifndef SKIP_NSA
                nsa_phase(lds, (const bf16_t*)(ws + WS_R + R_QN), KVb, (const bf16_t*)(ws + WS_KC), (const bf16_t*)(ws + WS_VC), (bf16_t*)(ws + WS_R + R_O));
#endif
            PHASE_END
            PHASE_BEGIN
            PHASE_END
            PHASE_BEGIN
                pg8::Gemm g{(const bf16_t*)(ws + WS_R + R_O), (const bf16_t*)(ws + W_NSA_OUT), M, D, D, D}; pg8::StaticOrder S; S.init(M, D, G, (int)blockIdx.x);
                pg8::Epi<pg8::EPI_RESID> E{pp->out, pp->out, D, ALPHA, 1.0f, nullptr, nullptr};
                if (GMASK & (1 << 5)) pg8::gemm_phase(lds, g, S, E);
            PHASE_END
        }
        PHASE_BEGIN
            ln_phase(pp->out, pp->out, Xb, pp->ln_g + layer * 3 * D + D, pp->ln_b + layer * 3 * D + D);
        PHASE_END
        PHASE_BEGIN
            pg8::Gemm g{Xb, (const bf16_t*)(ws + W_FFN2_IN), M, 2 * FF, D, D}; pg8::StaticOrder S; S.init(M, 2 * FF, G, (int)blockIdx.x);
            pg8::Epi<pg8::EPI_SWIGLU> E{Hb, nullptr, FF, 0.f, 0.f, nullptr, nullptr};
            if (GMASK & (1 << 6)) pg8::gemm_phase(lds, g, S, E);
        PHASE_END
        PHASE_BEGIN
            pg8::Gemm g{Hb, (const bf16_t*)(ws + W_FFN2_OUT), M, D, FF, FF}; pg8::StaticOrder S; S.init(M, D, G, (int)blockIdx.x);
            pg8::Epi<pg8::EPI_RESID> E{pp->out, pp->out, D, ALPHA, 0.5f, nullptr, nullptr};
            if (GMASK & (1 << 7)) pg8::gemm_phase(lds, g, S, E);
        PHASE_END
        PHASE_BEGIN
            ln_phase(pp->out, pp->out, Xb, pp->ln_g + layer * 3 * D + 2 * D, pp->ln_b + layer * 3 * D + 2 * D);
        PHASE_END
        if constexpr (layer == 0) {
            PHASE_BEGIN
                pg8::Gemm g{Xb, (const bf16_t*)(ws + W_KV), M, KVC, D, D}; pg8::StaticOrder S; S.init(M, KVC, G, (int)blockIdx.x);
                pg8::Epi<pg8::EPI_KV> E{KVb, nullptr, KVC, 1.f, 0.f, ncos, nsin};
                if (GMASK & (1 << 8)) pg8::gemm_phase(lds, g, S, E);
            PHASE_END
            PHASE_BEGIN
                cmp_gather_phase(KVb, pp->cmp_pos, (bf16_t*)(ws + WS_R + R_ACMP));
            PHASE_END
            PHASE_BEGIN
                if (blockIdx.x < 64) {
                pg8::Gemm g{(const bf16_t*)(ws + WS_R + R_ACMP), (const bf16_t*)(ws + W_CMP1), 8192, 1024, 4096, 4096}; pg8::CmpOrder S{G, (int)blockIdx.x};
                pg8::Epi<pg8::EPI_CMP1> E{(bf16_t*)(ws + WS_R + R_HC), pp->cmp_b1, 512, 0.f, 0.f, nullptr, nullptr};
                pg8::gemm_phase(lds, g, S, E);
                } else {
                const int gw = ((int)blockIdx.x - 64) * 8 + rfl((int)threadIdx.x >> 6), NGW = (G - 64) * 8;
                convert_part(lds, pp->ffn1_in + (size_t)D * 2 * FF, D, 2 * FF, 2 * FF, 1, (bf16_t*)(ws + W_FFN1_IN), gw, NGW);
                convert_part(lds, pp->ffn1_out + (size_t)FF * D, FF, D, D, 0, (bf16_t*)(ws + W_FFN1_OUT), gw, NGW);
                convert_part(lds, pp->ffn2_in + (size_t)D * 2 * FF, D, 2 * FF, 2 * FF, 1, (bf16_t*)(ws + W_FFN2_IN), gw, NGW);
                convert_part(lds, pp->ffn2_out + (size_t)FF * D, FF, D, D, 0, (bf16_t*)(ws + W_FFN2_OUT), gw, NGW);
                convert_part(lds, pp->nsa_q, D, 2096, NQC, 0, (bf16_t*)(ws + W_NSA_Q), gw, NGW);
                convert_part(lds, pp->nsa_out, D, D, D, 0, (bf16_t*)(ws + W_NSA_OUT), gw, NGW);
                }
            PHASE_END
            PHASE_BEGIN
                cmp2_phase((const bf16_t*)(ws + WS_R + R_HC), pp->cmp_w2, ncos, nsin, (bf16_t*)(ws + WS_KC), (bf16_t*)(ws + WS_VC));
            PHASE_END
        }
    }

__global__ void __launch_bounds__(512, 2) yoco_fwd(Params p) {
    extern __shared__ __attribute__((aligned(16))) unsigned char lds_raw[];
    ldsp lds = (ldsp)lds_raw;
    cg::grid_group grid = cg::this_grid();
    const int G = gridDim.x;
    const int lo = p.ph_lo, hi = p.ph_hi;
    int ph = 0;
    PHASE_BEGIN
        convert_one(lds, pp->ffn1_in, D, 2 * FF, 2 * FF, 1, (bf16_t*)(ws + W_FFN1_IN));
        convert_one(lds, pp->ffn1_out, FF, D, D, 0, (bf16_t*)(ws + W_FFN1_OUT));
        convert_one(lds, pp->ffn2_in, D, 2 * FF, 2 * FF, 1, (bf16_t*)(ws + W_FFN2_IN));
        convert_one(lds, pp->ffn2_out, FF, D, D, 0, (bf16_t*)(ws + W_FFN2_OUT));
        convert_one(lds, pp->ret_in, D, RETC, RETC, 0, (bf16_t*)(ws + W_RET_IN));
        convert_one(lds, pp->ret_out, 4096, D, D, 0, (bf16_t*)(ws + W_RET_OUT));
        convert_one(lds, pp->kv_w, D, KVC, KVC, 0, (bf16_t*)(ws + W_KV));
        convert_one(lds, pp->cmp_w1, 4096, 512, 512, 0, (bf16_t*)(ws + W_CMP1));
        convert_one(lds, pp->cmp_w1 + (size_t)4096 * 512, 4096, 512, 512, 0, (bf16_t*)(ws + W_CMP1) + (size_t)512 * 4096);
        const size_t gt = (size_t)blockIdx.x * 512 + threadIdx.x, NT = (size_t)G * 512;
        for (size_t i = gt; i < (size_t)2048 * 128; i += NT) { const int pos = (int)(i >> 7), f = (int)(i & 127); const float inv = powf(10000.f, -(float)f / 128.f); const float ang = (float)pos * inv; rcos[i] = COSF(ang); rsin[i] = SINF(ang); }
        for (size_t i = gt; i < (size_t)2048 * 16; i += NT) { const int pos = (int)(i >> 4), f = (int)(i & 15); const float inv = powf(500000.f, -(float)f / 16.f); const float ang = (float)pos * inv; ncos[i] = COSF(ang); nsin[i] = SINF(ang); }
        for (size_t i = gt; i < (size_t)M * D / 8; i += NT) { const f32x4 a = *(const f32x4*)(pp->x + i * 8), b2 = *(const f32x4*)(pp->x + i * 8 + 4); u32x4 w; w.x = pk2(a[0], a[1]); w.y = pk2(a[2], a[3]); w.z = pk2(b2[0], b2[1]); w.w = pk2(b2[2], b2[3]); *(u32x4*)(Xb + i * 8) = w; }
    PHASE_END

    run_layer<0>(lds, grid, lo, hi, ph, G);
    run_layer<1>(lds, grid, lo, hi, ph, G);
#undef PHASE_BEGIN
#undef PHASE_END
}

#ifndef N_LAUNCH_MODE
#define N_LAUNCH_MODE 1
#endif
extern "C" void kernel_launch(void* const* d_in, const int* in_sizes, int n_in, void* d_out, int out_size, void* d_ws, size_t ws_size, hipStream_t stream) {
    static int inited = 0;
    if (!inited) { (void)hipFuncSetAttribute((const void*)yoco_fwd, hipFuncAttributeMaxDynamicSharedMemorySize, LDS_BYTES); inited = 1; }
    Params p{};
    p.x = (const float*)d_in[0]; p.ln_g = (const float*)d_in[1]; p.ln_b = (const float*)d_in[2];
    p.ffn1_in = (const float*)d_in[3]; p.ffn1_out = (const float*)d_in[4]; p.ffn2_in = (const float*)d_in[5]; p.ffn2_out = (const float*)d_in[6];
    p.ret_in = (const float*)d_in[7]; p.gn_g = (const float*)d_in[8]; p.gn_b = (const float*)d_in[9]; p.ret_out = (const float*)d_in[10];
    p.kv_w = (const float*)d_in[11]; p.cmp_pos = (const float*)d_in[12]; p.cmp_w1 = (const float*)d_in[13]; p.cmp_b1 = (const float*)d_in[14]; p.cmp_w2 = (const float*)d_in[15];
    p.nsa_q = (const float*)d_in[16]; p.nsa_out = (const float*)d_in[17];
    p.out = (float*)d_out; p.ws = (unsigned char*)d_ws;
#if N_LAUNCH_MODE == 1
    p.ph_lo = 0; p.ph_hi = 64;
    void* args[] = {&p};
    hipError_t e = hipLaunchCooperativeKernel((const void*)yoco_fwd, dim3(256), dim3(512), args, LDS_BYTES, stream);
    if (e != hipSuccess) fprintf(stderr, "cooperative launch failed: %s\n", hipGetErrorString(e));
#else
    for (int ph = 0; ph < 32; ++ph) { p.ph_lo = ph; p.ph_hi = ph + 1; hipLaunchKernelGGL(yoco_fwd, dim3(256), dim3(512), LDS_BYTES, stream, p); }
#endif
}
```

```cpp
#include <hip/hip_runtime.h>
#include <hip/hip_cooperative_groups.h>
#include <cstdint>
#include <cstdio>
namespace cg = cooperative_groups;

#define LAS __attribute__((address_space(3)))
typedef unsigned short bf16_t;
typedef short bf16x8 __attribute__((ext_vector_type(8)));
typedef short s16x4 __attribute__((ext_vector_type(4)));
typedef float f32x4 __attribute__((ext_vector_type(4)));
typedef float f32x16 __attribute__((ext_vector_type(16)));
typedef unsigned u32x4 __attribute__((ext_vector_type(4)));
typedef unsigned u32x2 __attribute__((ext_vector_type(2)));
typedef LAS unsigned char* ldsp;

constexpr int BATCH = 8, T = 2048, D = 2048, M = BATCH * T, FF = 5632;
constexpr int RETC = 12288;
constexpr int KVC = 3072, NQC = 2304;
constexpr float ALPHA = 1.41421356237f, LN_EPS = 1e-5f;
constexpr float QSCALE = 0.08838834764831845f * 1.4426950408889634f;
constexpr int RC = 64;

constexpr size_t MiB = 1u << 20;
constexpr size_t W_FFN1_IN = 0;
constexpr size_t W_FFN1_OUT = W_FFN1_IN + (size_t)2 * FF * D * 2;
constexpr size_t W_FFN2_IN = W_FFN1_OUT + (size_t)D * FF * 2;
constexpr size_t W_FFN2_OUT = W_FFN2_IN + (size_t)2 * FF * D * 2;
constexpr size_t W_X0 = W_FFN2_OUT + (size_t)D * FF * 2;
constexpr size_t W_RET_IN = W_X0;
constexpr size_t W_RET_OUT = W_RET_IN + (size_t)RETC * D * 2;
constexpr size_t W_KV = W_RET_OUT + (size_t)D * 4096 * 2;
constexpr size_t W_CMP1 = W_KV + (size_t)KVC * D * 2;
constexpr size_t W_END0 = W_CMP1 + (size_t)1024 * 4096 * 2;
constexpr size_t W_NSA_Q = W_X0;
constexpr size_t W_NSA_OUT = W_NSA_Q + (size_t)NQC * D * 2;
constexpr size_t WS_XB = 216 * MiB;
constexpr size_t WS_KV = 280 * MiB;
constexpr size_t WS_R = 376 * MiB;
constexpr size_t WS_KC = 760 * MiB, WS_VC = 761 * MiB;
constexpr size_t WS_ROPE_R = 762 * MiB;
constexpr size_t WS_ROPE_N = 764 * MiB;
constexpr size_t WS_CNT = 765 * MiB;
constexpr size_t WS_XBUF = 766 * MiB;
static_assert(W_END0 <= WS_XB, "weights region");
constexpr size_t R_H = 0;
constexpr size_t R_ACMP = 0;
constexpr size_t R_HC = 64 * MiB;
constexpr size_t R_QN = 0;
constexpr size_t R_O = 72 * MiB;

constexpr int LDS_BYTES = 143360;

__device__ __forceinline__ int opaque_tid() { int t = threadIdx.x; asm volatile("" : "+v"(t)); return t; }
__device__ __forceinline__ int rfl(int v) { return __builtin_amdgcn_readfirstlane(v); }
__device__ __forceinline__ unsigned f2bf(float f) { unsigned u = __builtin_bit_cast(unsigned, f); return (u + 0x7fffu + ((u >> 16) & 1u)) >> 16; }
__device__ __forceinline__ unsigned pk2(float lo, float hi) { unsigned r; asm volatile("v_cvt_pk_bf16_f32 %0, %1, %2" : "=v"(r) : "v"(lo), "v"(hi)); return r; }
__device__ __forceinline__ float bf2f(unsigned short b) { return __builtin_bit_cast(float, (unsigned)b << 16); }
__device__ __forceinline__ float bflo(unsigned w) { return __builtin_bit_cast(float, w << 16); }
__device__ __forceinline__ float bfhi(unsigned w) { return __builtin_bit_cast(float, w & 0xffff0000u); }
__device__ __forceinline__ float ex2(float x) { return __builtin_amdgcn_exp2f(x); }
__device__ __forceinline__ float siluf(float a) { return a * __builtin_amdgcn_rcpf(1.f + ex2(-1.4426950408889634f * a)); }
__device__ __forceinline__ float sigmf(float a) { return __builtin_amdgcn_rcpf(1.f + ex2(-1.4426950408889634f * a)); }
__device__ __forceinline__ float gelu_tanh(float x) {
    const float u = 0.7978845608028654f * (x + 0.044715f * x * x * x);
    const float e = ex2(2.8853900817779268f * u);
    const float th = 1.f - 2.f * __builtin_amdgcn_rcpf(e + 1.f);
    return 0.5f * x * (1.f + th);
}
__device__ __forceinline__ float wave_sum(float v) {
#pragma unroll
    for (int o = 1; o < 64; o <<= 1) v += __shfl_xor(v, o);
    return v;
}
__device__ __forceinline__ f32x4 mfma16(bf16x8 a, bf16x8 b, f32x4 c) { return __builtin_amdgcn_mfma_f32_16x16x32_bf16(a, b, c, 0, 0, 0); }
__device__ __forceinline__ f32x16 mfma32(bf16x8 a, bf16x8 b, f32x16 c) { return __builtin_amdgcn_mfma_f32_32x32x16_bf16(a, b, c, 0, 0, 0); }
typedef short v4i16_t __attribute__((ext_vector_type(4)));
__device__ __forceinline__ s16x4 trrd(ldsp p) { return __builtin_bit_cast(s16x4, __builtin_amdgcn_ds_read_tr16_b64_v4i16((LAS v4i16_t*)p)); }
__device__ __forceinline__ bf16x8 cat8(s16x4 lo, s16x4 hi) { return (bf16x8){lo[0], lo[1], lo[2], lo[3], hi[0], hi[1], hi[2], hi[3]}; }
__device__ __forceinline__ int vcu_of() { const int G = gridDim.x, bx = blockIdx.x; return (G % 8 == 0) ? (bx % 8) * (G / 8) + bx / 8 : bx; }

namespace pg8 {
constexpr int BM = 256, BK = 64, HALF = 128, HTB = HALF * BK * 2, STAGE_BYTES = 8 * HTB, NXCD = 8, WGM = 8;
__host__ __device__ __forceinline__ int lds_byte(int r, int c) { const int st = (r >> 4) * 2 + (c >> 5), rr = r & 15, cc = c & 31, ob = rr * 64 + cc * 2; return st * 1024 + (ob ^ (((ob >> 9) & 1) << 5)); }
__host__ __device__ __forceinline__ void stage_rc(int b, int& R, int& C) { const int st = b / 1024, sb = b % 1024, swz = sb ^ (((sb >> 9) & 1) << 5); R = (st >> 1) * 16 + swz / 64; C = (st & 1) * 32 + (swz % 64) / 2; }
__host__ __device__ __forceinline__ int perm32(int rho) { const int n = rho >> 4, i = rho & 15; return 8 * (i >> 2) + 4 * n + (i & 3); }
struct Unit { int pm, pn; };
struct Gemm { const bf16_t* A; const bf16_t* Bt; int M, N, K, lda; };
struct StaticOrder {
    int nM, nN, nwg, G, c;
    __device__ void init(int M_, int N_, int G_, int c_) { nM = M_ / BM; nN = N_ / BM; nwg = nM * nN; G = G_; c = c_; }
    __device__ bool next(int i, Unit& u) const {
        const long L = (long)i * G + c; if (L >= nwg) return false;
        int wgid = (int)L; { const int q = nwg / NXCD, r = nwg % NXCD, xcd = wgid % NXCD, off = wgid / NXCD; wgid = (xcd < r ? xcd * (q + 1) : r * (q + 1) + (xcd - r) * q) + off; }
        const int nig = WGM * nN, gid = wgid / nig, fm = gid * WGM, gsz = (nM - fm) < WGM ? (nM - fm) : WGM;
        u.pm = fm + ((wgid % nig) % gsz); u.pn = (wgid % nig) / gsz; return true;
    }
};
struct CmpOrder {
    int G, c;
    __device__ bool next(int i, Unit& u) const { const int L = i * G + c; if (L >= 64) return false; const int cc = L >> 5, r = L & 31; u.pm = cc * 16 + (r >> 1); u.pn = cc * 2 + (r & 1); return true; }
};

enum { EPI_SWIGLU = 0, EPI_RESID = 1, EPI_RET = 2, EPI_KV = 3, EPI_NSAQ = 4, EPI_CMP1 = 5 };
template <int MODE> struct Epi {
    static constexpr bool PERM = (MODE == EPI_SWIGLU || MODE == EPI_RET || MODE == EPI_CMP1);
    void* out; const float* src; int ldc; float alpha, beta; const float* tcos; const float* tsin;
    __device__ __forceinline__ void operator()(f32x4 (&acc)[2][2][4][2], const Unit& u, int wr, int wc, int fr, int fq) const {
        if constexpr (MODE == EPI_SWIGLU) {
            bf16_t* O = (bf16_t*)out; const int col0 = u.pn * 128 + wc * 32 + 8 * fq;
#pragma unroll
            for (int ai = 0; ai < 2; ++ai)
#pragma unroll
                for (int m = 0; m < 4; ++m) {
                    const int row = u.pm * BM + ai * HALF + wr * 64 + m * 16 + fr;
                    const f32x4 a0 = acc[ai][0][m][0], a1 = acc[ai][0][m][1], u0 = acc[ai][1][m][0], u1 = acc[ai][1][m][1];
                    u32x4 w; w.x = pk2(siluf(a0[0]) * u0[0], siluf(a0[1]) * u0[1]); w.y = pk2(siluf(a0[2]) * u0[2], siluf(a0[3]) * u0[3]);
                    w.z = pk2(siluf(a1[0]) * u1[0], siluf(a1[1]) * u1[1]); w.w = pk2(siluf(a1[2]) * u1[2], siluf(a1[3]) * u1[3]);
                    *(u32x4*)(O + (size_t)row * ldc + col0) = w;
                }
        } else if constexpr (MODE == EPI_RESID) {
            float* Y = (float*)out; const int col0 = u.pn * BM + wc * 32 + 4 * fq;
#pragma unroll
            for (int ai = 0; ai < 2; ++ai)
#pragma unroll
                for (int m = 0; m < 4; ++m) {
                    const int row = u.pm * BM + ai * HALF + wr * 64 + m * 16 + fr; const size_t off = (size_t)row * ldc + col0;
#pragma unroll
                    for (int bj = 0; bj < 2; ++bj)
#pragma unroll
                        for (int n = 0; n < 2; ++n) { const f32x4 x = *(const f32x4*)(src + off + bj * HALF + n * 16); *(f32x4*)(Y + off + bj * HALF + n * 16) = x * alpha + acc[ai][bj][m][n] * beta; }
                    asm volatile("" ::: "memory");
                }
        } else if constexpr (MODE == EPI_RET) {
            bf16_t* O = (bf16_t*)out; const int colw = wc * 32 + 8 * fq;
            if (u.pn < 16) {
                const bool isk = u.pn >= 8; const int hh = u.pn & 7; const float l2g = __builtin_log2f(1.f - ex2(-5.f - (float)hh));
#pragma unroll
                for (int ai = 0; ai < 2; ++ai)
#pragma unroll
                    for (int m = 0; m < 4; ++m) {
                        const int row = u.pm * BM + ai * HALF + wr * 64 + m * 16 + fr, pos = row & (T - 1);
                        const float sc = isk ? 0.0625f * ex2(l2g * (float)(RC - 1 - (pos & (RC - 1)))) : 1.f;
                        f32x4 o1[2], o2[2];
#pragma unroll
                        for (int n = 0; n < 2; ++n) { const f32x4 cs = *(const f32x4*)(tcos + pos * 128 + colw + 4 * n), sn = *(const f32x4*)(tsin + pos * 128 + colw + 4 * n);
                            const f32x4 x1 = acc[ai][0][m][n], x2 = acc[ai][1][m][n]; o1[n] = (x1 * cs - x2 * sn) * sc; o2[n] = (x2 * cs + x1 * sn) * sc; }
                        bf16_t* rp = O + (size_t)row * ldc + u.pn * BM + colw;
                        u32x4 w; w.x = pk2(o1[0][0], o1[0][1]); w.y = pk2(o1[0][2], o1[0][3]); w.z = pk2(o1[1][0], o1[1][1]); w.w = pk2(o1[1][2], o1[1][3]); *(u32x4*)rp = w;
                        w.x = pk2(o2[0][0], o2[0][1]); w.y = pk2(o2[0][2], o2[0][3]); w.z = pk2(o2[1][0], o2[1][1]); w.w = pk2(o2[1][2], o2[1][3]); *(u32x4*)(rp + HALF) = w;
                        asm volatile("" ::: "memory");
                    }
            } else {
#pragma unroll
                for (int ai = 0; ai < 2; ++ai)
#pragma unroll
                    for (int m = 0; m < 4; ++m) {
                        const int row = u.pm * BM + ai * HALF + wr * 64 + m * 16 + fr; bf16_t* rp = O + (size_t)row * ldc + u.pn * BM + colw;
#pragma unroll
                        for (int bj = 0; bj < 2; ++bj) { const f32x4 v0 = acc[ai][bj][m][0], v1 = acc[ai][bj][m][1]; u32x4 w; w.x = pk2(v0[0], v0[1]); w.y = pk2(v0[2], v0[3]); w.z = pk2(v1[0], v1[1]); w.w = pk2(v1[2], v1[3]); *(u32x4*)(rp + bj * HALF) = w; }
                    }
            }
        } else if constexpr (MODE == EPI_KV || MODE == EPI_NSAQ) {
            bf16_t* O = (bf16_t*)out;
            bool rope; float sc = 1.f;
            if constexpr (MODE == EPI_KV) { const int cidx = u.pn >> 1; rope = (cidx == 2 || cidx == 4) && wc == 0; }
            else { rope = (u.pn < 8) && wc == 0; sc = (u.pn < 8) ? alpha : 1.f; }
#pragma unroll
            for (int ai = 0; ai < 2; ++ai)
#pragma unroll
                for (int m = 0; m < 4; ++m) {
                    const int row = u.pm * BM + ai * HALF + wr * 64 + m * 16 + fr, pos = row & (T - 1);
                    f32x4 cs = (f32x4){1.f, 1.f, 1.f, 1.f}, sn = (f32x4){0.f, 0.f, 0.f, 0.f};
                    if (rope) { cs = *(const f32x4*)(tcos + pos * 16 + 4 * fq); sn = *(const f32x4*)(tsin + pos * 16 + 4 * fq); }
                    bf16_t* rp = O + (size_t)row * ldc + u.pn * BM + wc * 32 + 4 * fq;
#pragma unroll
                    for (int bj = 0; bj < 2; ++bj) { const f32x4 x1 = acc[ai][bj][m][0], x2 = acc[ai][bj][m][1];
                        const f32x4 o1 = (x1 * cs - x2 * sn) * sc, o2 = (x2 * cs + x1 * sn) * sc;
                        u32x2 w; w.x = pk2(o1[0], o1[1]); w.y = pk2(o1[2], o1[3]); *(u32x2*)(rp + bj * HALF) = w;
                        w.x = pk2(o2[0], o2[1]); w.y = pk2(o2[2], o2[3]); *(u32x2*)(rp + bj * HALF + 16) = w; }
                    asm volatile("" ::: "memory");
                }
        } else {
            bf16_t* O = (bf16_t*)out; const int colw = wc * 32 + 8 * fq;
#pragma unroll
            for (int ai = 0; ai < 2; ++ai)
#pragma unroll
                for (int m = 0; m < 4; ++m) {
                    const int row = u.pm * BM + ai * HALF + wr * 64 + m * 16 + fr; bf16_t* rp = O + (size_t)row * ldc + (u.pn & 1) * BM + colw;
#pragma unroll
                    for (int bj = 0; bj < 2; ++bj) { const float* bp = src + u.pn * BM + bj * HALF + colw; const f32x4 b0 = *(const f32x4*)bp, b1 = *(const f32x4*)(bp + 4);
                        const f32x4 v0 = acc[ai][bj][m][0] + b0, v1 = acc[ai][bj][m][1] + b1; u32x4 w;
                        w.x = pk2(gelu_tanh(v0[0]), gelu_tanh(v0[1])); w.y = pk2(gelu_tanh(v0[2]), gelu_tanh(v0[3])); w.z = pk2(gelu_tanh(v1[0]), gelu_tanh(v1[1])); w.w = pk2(gelu_tanh(v1[2]), gelu_tanh(v1[3]));
                        *(u32x4*)(rp + bj * HALF) = w; }
                    asm volatile("" ::: "memory");
                }
        }
    }
};

struct LnOrder {
    int vcu;
    __device__ bool next(int i, Unit& u) const { if (i >= 2) return false; u.pm = 32 * i + (vcu >> 3); u.pn = vcu & 7; return true; }
};
struct EpiLN {
    static constexpr bool PERM = false;
    float* dst; const float* src; bf16_t* xb; const float* g; const float* b; float alpha, beta;
    unsigned long long* xbuf; unsigned* cnt; ldsp xl; int live;
    __device__ __forceinline__ void operator()(f32x4 (&acc)[2][2][4][2], const Unit& u, int wr, int wc, int fr_in, int fq_in) const {
        typedef float f32x2v __attribute__((ext_vector_type(2)));
        int tid = threadIdx.x; asm volatile("" : "+v"(tid));
        const int wid = rfl(tid >> 6), lane = tid & 63, fr = lane & 15, fq = lane >> 4; (void)fr_in; (void)fq_in;
        LAS f32x2v* P = (LAS f32x2v*)xl; LAS f32x2v* S = (LAS f32x2v*)(xl + 8192);
        const int col0 = u.pn * BM + wc * 32 + 4 * fq;
#pragma unroll
        for (int ai = 0; ai < 2; ++ai)
#pragma unroll
            for (int m = 0; m < 4; ++m) { const size_t off = (size_t)(u.pm * BM + ai * HALF + wr * 64 + m * 16 + fr) * D + col0;
#pragma unroll
                for (int bj = 0; bj < 2; ++bj)
#pragma unroll
                    for (int n = 0; n < 2; ++n) { const f32x4 x = *(const f32x4*)(src + off + bj * HALF + n * 16); acc[ai][bj][m][n] = x * alpha + acc[ai][bj][m][n] * beta; }
                asm volatile("" : "+v"(acc[ai][0][m][0]), "+v"(acc[ai][0][m][1]), "+v"(acc[ai][1][m][0]), "+v"(acc[ai][1][m][1]));
                asm volatile("" ::: "memory"); }
#pragma unroll
        for (int ai = 0; ai < 2; ++ai)
#pragma unroll
            for (int m = 0; m < 4; ++m) {
                float sm = 0.f;
#pragma unroll
                for (int bj = 0; bj < 2; ++bj)
#pragma unroll
                    for (int n = 0; n < 2; ++n) { const f32x4 x = acc[ai][bj][m][n]; sm += (x[0] + x[1]) + (x[2] + x[3]); }
                sm += __shfl_xor(sm, 16); sm += __shfl_xor(sm, 32);
                const float mw = sm * (1.0f / 64.0f); float q = 0.f;
#pragma unroll
                for (int bj = 0; bj < 2; ++bj)
#pragma unroll
                    for (int n = 0; n < 2; ++n) { const f32x4 d = acc[ai][bj][m][n] - mw; q += (d[0] * d[0] + d[1] * d[1]) + (d[2] * d[2] + d[3] * d[3]); }
                q += __shfl_xor(q, 16); q += __shfl_xor(q, 32);
                if (fq == 0) P[(ai * HALF + wr * 64 + m * 16 + fr) * 4 + wc] = (f32x2v){mw, q};
            }
        asm volatile("s_waitcnt lgkmcnt(0)" ::: "memory"); __builtin_amdgcn_s_barrier(); asm volatile("" ::: "memory");
        const int row = wid * 32 + (lane & 31);
        if (lane < 32) {
            const f32x2v a = P[row * 4 + 0], bq = P[row * 4 + 1], c = P[row * 4 + 2], d = P[row * 4 + 3];
            const float mt = (a.x + bq.x + c.x + d.x) * 0.25f;
            const float da = a.x - mt, db = bq.x - mt, dc = c.x - mt, dd = d.x - mt;
            const float m2 = (a.y + bq.y) + (c.y + d.y) + 64.0f * ((da * da + db * db) + (dc * dc + dd * dd));
            unsigned long long* slot = xbuf + ((size_t)(u.pm * BM + row) * 8 + u.pn);
            __hip_atomic_store(slot, ((unsigned long long)__float_as_uint(m2) << 32) | __float_as_uint(mt), __ATOMIC_RELAXED, __HIP_MEMORY_SCOPE_AGENT);
        }
        asm volatile("s_waitcnt vmcnt(0)" ::: "memory");
        if (lane == 0) __hip_atomic_fetch_add(cnt + 64 * u.pm, 1u, __ATOMIC_RELAXED, __HIP_MEMORY_SCOPE_AGENT);
        if (wid == 0) {
            unsigned spins = 0;
            while (live) {
                if ((unsigned)__builtin_amdgcn_readfirstlane(__hip_atomic_load(cnt + 64 * u.pm, __ATOMIC_RELAXED, __HIP_MEMORY_SCOPE_AGENT)) >= 64u) break;
                if (++spins > (1u << 22)) break;
                __builtin_amdgcn_s_sleep(2);
            }
            __builtin_amdgcn_fence(__ATOMIC_ACQUIRE, "agent");
        }
        asm volatile("s_waitcnt vmcnt(0) lgkmcnt(0)" ::: "memory"); __builtin_amdgcn_s_barrier(); asm volatile("" ::: "memory");
        if (lane < 32) {
            const unsigned long long* slot = xbuf + (size_t)(u.pm * BM + row) * 8; float mt[8], m2[8]; float ms = 0.f;
#pragma unroll
            for (int t = 0; t < 8; ++t) { const unsigned long long w = __hip_atomic_load(slot + t, __ATOMIC_RELAXED, __HIP_MEMORY_SCOPE_AGENT); mt[t] = __uint_as_float((unsigned)w); m2[t] = __uint_as_float((unsigned)(w >> 32)); ms += mt[t]; }
            const float mean = ms * 0.125f; float q = 0.f;
#pragma unroll
            for (int t = 0; t < 8; ++t) { const float dm = mt[t] - mean; q += m2[t] + 256.0f * dm * dm; }
            S[row] = (f32x2v){mean, 1.0f / sqrtf(q * (1.0f / 2048.0f) + LN_EPS)};
        }
        asm volatile("s_waitcnt lgkmcnt(0)" ::: "memory"); __builtin_amdgcn_s_barrier(); asm volatile("" ::: "memory");
        int col5 = col0; asm volatile("" : "+v"(col5));
#pragma unroll
        for (int bj = 0; bj < 2; ++bj)
#pragma unroll
            for (int n = 0; n < 2; ++n) { const f32x4 gv = *(const f32x4*)(g + col5 + bj * HALF + n * 16), bv = *(const f32x4*)(b + col5 + bj * HALF + n * 16);
#pragma unroll
                for (int ai = 0; ai < 2; ++ai)
#pragma unroll
                    for (int m = 0; m < 4; ++m) { const int r = ai * HALF + wr * 64 + m * 16 + fr; const f32x2v sr = S[r]; const size_t off = (size_t)(u.pm * BM + r) * D + col5 + bj * HALF + n * 16;
                        const f32x4 o = (acc[ai][bj][m][n] - sr.x) * sr.y * gv + bv; *(f32x4*)(dst + off) = o;
                        u32x2 w; w.x = pk2(o[0], o[1]); w.y = pk2(o[2], o[3]); *(u32x2*)(xb + off) = w; }
                asm volatile("" ::: "memory"); }
        asm volatile("s_waitcnt lgkmcnt(0)" ::: "memory"); __builtin_amdgcn_s_barrier(); asm volatile("" ::: "memory");
    }
};

template <class Epi, class Sched>
__device__ __forceinline__ void gemm_phase(ldsp lds, const Gemm g, const Sched& S, const Epi& E) {
    const int tid = opaque_tid(), wid = __builtin_amdgcn_readfirstlane(tid >> 6), lane = tid & 63, wr = wid >> 2, wc = wid & 3, fr = lane & 15, fq = lane >> 4;
    const int K = g.K, nt = K / BK, lda = g.lda;
    unsigned voffA[2], voffB[2];
#pragma unroll
    for (int i = 0; i < 2; ++i) { int R, C; stage_rc(tid * 16 + i * 8192, R, C); const int Rb = Epi::PERM ? ((R & ~31) + perm32(R & 31)) : R;
        voffA[i] = (unsigned)(R * lda + C) * 2u; voffB[i] = (unsigned)(Rb * K + C) * 2u; }
    const size_t kstep = (size_t)(BK * 2);
    const size_t hstepA = (size_t)HALF * lda * 2, hstepB = (size_t)HALF * K * 2;
    const size_t tstepA = 2 * hstepA, tstepB = 2 * hstepB;
    const unsigned ldsw = (unsigned)wid * 1024u;
    const int aoff = lds_byte(wr * 64 + fr, fq * 8), boff = lds_byte(wc * 32 + fr, fq * 8);
#define PG8_SA(b, h) (((b) * 2 + (h)) * HTB)
#define PG8_SB(b, h) ((4 + (b) * 2 + (h)) * HTB)
#define PG8_STAGE(bufoff, gbase, voff) do { _Pragma("unroll") for (int _i = 0; _i < 2; ++_i) \
        __builtin_amdgcn_global_load_lds((const unsigned*)((const char*)(gbase) + (voff)[_i]), (LAS unsigned*)(lds + (bufoff) + ldsw + _i * 8192), 16, 0, 0); } while (0)
#define PG8_LDA(dst, b, h) do { _Pragma("unroll") for (int m = 0; m < 4; ++m) _Pragma("unroll") for (int k = 0; k < 2; ++k) dst[m][k] = *(const LAS bf16x8*)(lds + PG8_SA(b, h) + aoff + m * 2048 + k * 1024); } while (0)
#define PG8_LDB(dst, b, h) do { _Pragma("unroll") for (int n = 0; n < 2; ++n) _Pragma("unroll") for (int k = 0; k < 2; ++k) dst[n][k] = *(const LAS bf16x8*)(lds + PG8_SB(b, h) + boff + n * 2048 + k * 1024); } while (0)
#define PG8_MMA(ai, bj, At, Bt) do { __builtin_amdgcn_s_setprio(1); _Pragma("unroll") for (int m = 0; m < 4; ++m) _Pragma("unroll") for (int n = 0; n < 2; ++n) _Pragma("unroll") for (int k = 0; k < 2; ++k) \
        acc[ai][bj][m][n] = __builtin_amdgcn_mfma_f32_16x16x32_bf16(Bt[n][k], At[m][k], acc[ai][bj][m][n], 0, 0, 0); __builtin_amdgcn_s_setprio(0); } while (0)
#define PG8_WAIT_V(n) asm volatile("s_waitcnt vmcnt(" #n ")" ::: "memory")
#define PG8_WAIT_L(n) asm volatile("s_waitcnt lgkmcnt(" #n ")" ::: "memory")
#define PG8_BAR __builtin_amdgcn_s_barrier()
#define PG8_SCHED __builtin_amdgcn_sched_barrier(0)
    Unit cur, nxt; int ui = 0;
    if (!S.next(0, cur)) return;
    f32x4 acc[2][2][4][2];
#pragma unroll
    for (int a = 0; a < 2; ++a)
#pragma unroll
        for (int b = 0; b < 2; ++b)
#pragma unroll
            for (int m = 0; m < 4; ++m)
#pragma unroll
                for (int n = 0; n < 2; ++n) acc[a][b][m][n] = (f32x4){0.f, 0.f, 0.f, 0.f};
    bf16x8 At[4][2], B0[2][2], B1[2][2];
    const char* cA = (const char*)g.A + (size_t)cur.pm * tstepA; const char* cB = (const char*)g.Bt + (size_t)cur.pn * tstepB;
    PG8_STAGE(PG8_SB(0, 0), cB, voffB); PG8_STAGE(PG8_SB(0, 1), cB + hstepB, voffB); PG8_STAGE(PG8_SA(0, 0), cA, voffA); PG8_STAGE(PG8_SA(0, 1), cA + hstepA, voffA);
    if (wr == 1) PG8_BAR;
    PG8_WAIT_V(2); PG8_BAR;
    PG8_STAGE(PG8_SB(1, 0), cB + kstep, voffB); PG8_STAGE(PG8_SA(1, 0), cA + kstep, voffA); PG8_STAGE(PG8_SB(1, 1), cB + hstepB + kstep, voffB);
    PG8_WAIT_V(6); PG8_BAR;
    for (;;) {
        const bool has_next = S.next(ui + 1, nxt);
        const char* nA = has_next ? (const char*)g.A + (size_t)nxt.pm * tstepA : cA; const char* nB = has_next ? (const char*)g.Bt + (size_t)nxt.pn * tstepB : cB;
        for (int t = 0; t < nt; t += 2) {
            const bool last = (t == nt - 2);
            const char* a1 = cA + (size_t)(t + 1) * kstep;
            const char* a2 = last ? nA : cA + (size_t)(t + 2) * kstep; const char* b2 = last ? nB : cB + (size_t)(t + 2) * kstep;
            const char* a3 = a2 + kstep; const char* b3 = b2 + kstep;
            PG8_LDB(B0, 0, 0); PG8_LDB(B1, 0, 1); PG8_SCHED; PG8_LDA(At, 0, 0); PG8_STAGE(PG8_SA(1, 1), a1 + hstepA, voffA);
            PG8_WAIT_V(8); PG8_WAIT_L(0); PG8_BAR; PG8_MMA(0, 0, At, B0); PG8_MMA(0, 1, At, B1); PG8_BAR; PG8_SCHED;
            PG8_LDA(At, 0, 1); PG8_STAGE(PG8_SB(0, 0), b2, voffB); PG8_STAGE(PG8_SB(0, 1), b2 + hstepB, voffB); PG8_STAGE(PG8_SA(0, 0), a2, voffA);
            PG8_WAIT_V(8); PG8_WAIT_L(0); PG8_BAR; PG8_MMA(1, 0, At, B0); PG8_MMA(1, 1, At, B1); PG8_BAR; PG8_SCHED;
            PG8_LDB(B0, 1, 0); PG8_LDB(B1, 1, 1); PG8_SCHED; PG8_LDA(At, 1, 0); PG8_STAGE(PG8_SA(0, 1), a2 + hstepA, voffA);
            PG8_WAIT_V(8); PG8_WAIT_L(0); PG8_BAR; PG8_MMA(0, 0, At, B0); PG8_MMA(0, 1, At, B1); PG8_BAR; PG8_SCHED;
            PG8_LDA(At, 1, 1); PG8_STAGE(PG8_SB(1, 0), b3, voffB); PG8_STAGE(PG8_SB(1, 1), b3 + hstepB, voffB); PG8_STAGE(PG8_SA(1, 0), a3, voffA);
            PG8_WAIT_V(8); PG8_WAIT_L(0); PG8_BAR; PG8_MMA(1, 0, At, B0); PG8_MMA(1, 1, At, B1); PG8_BAR; PG8_SCHED;
        }
        if (wr == 0) PG8_BAR;
        E(acc, cur, wr, wc, fr, fq);
        if (!has_next) break;
#pragma unroll
        for (int a = 0; a < 2; ++a)
#pragma unroll
            for (int b = 0; b < 2; ++b)
#pragma unroll
                for (int m = 0; m < 4; ++m)
#pragma unroll
                    for (int n = 0; n < 2; ++n) acc[a][b][m][n] = (f32x4){0.f, 0.f, 0.f, 0.f};
        cur = nxt; cA = nA; cB = nB; ++ui;
        if (wr == 1) PG8_BAR;
    }
    PG8_WAIT_V(0);
    PG8_BAR;
#undef PG8_SA
#undef PG8_SB
#undef PG8_STAGE
#undef PG8_LDA
#undef PG8_LDB
#undef PG8_MMA
#undef PG8_WAIT_V
#undef PG8_WAIT_L
#undef PG8_BAR
#undef PG8_SCHED
}
}

struct Params {
    const float* x; const float* ln_g; const float* ln_b;
    const float* ffn1_in; const float* ffn1_out; const float* ffn2_in; const float* ffn2_out;
    const float* ret_in; const float* gn_g; const float* gn_b; const float* ret_out;
    const float* kv_w; const float* cmp_pos; const float* cmp_w1; const float* cmp_b1; const float* cmp_w2;
    const float* nsa_q; const float* nsa_out;
    float* out; unsigned char* ws;
    int ph_lo, ph_hi;
};

__device__ __forceinline__ int dest_row(int n, int mode) { if (mode == 0) return n; const int isu = n >= FF ? 1 : 0, j = n - isu * FF; return (j >> 7) * 256 + isu * 128 + (j & 127); }
__device__ __forceinline__ void transpose_item(const float* W, int K, int N, bf16_t* WT, int mode, LAS float* scr, int item, int nblk, int lane) {
    const int kb = item / nblk, nb = item % nblk, k0 = 64 * kb, n0 = 64 * nb;
    const int nq = 4 * (lane & 15), kr = lane >> 4;
    const bool inb = (n0 + nq) < N;
    f32x4 v[16];
#pragma unroll
    for (int i = 0; i < 16; ++i) v[i] = inb ? *(const f32x4*)(W + (size_t)(k0 + 4 * i + kr) * N + n0 + nq) : (f32x4){0.f, 0.f, 0.f, 0.f};
#pragma unroll
    for (int i = 0; i < 16; ++i) { LAS float* d = scr + (4 * i + kr) * 65 + nq; d[0] = v[i][0]; d[1] = v[i][1]; d[2] = v[i][2]; d[3] = v[i][3]; }
    asm volatile("s_waitcnt lgkmcnt(0)" ::: "memory");
    const int c = lane & 7;
#pragma unroll
    for (int j = 0; j < 8; ++j) { const int n = (lane >> 3) + 8 * j; const LAS float* sp = scr + (8 * c) * 65 + n;
        u32x4 o; o.x = pk2(sp[0 * 65], sp[1 * 65]); o.y = pk2(sp[2 * 65], sp[3 * 65]); o.z = pk2(sp[4 * 65], sp[5 * 65]); o.w = pk2(sp[6 * 65], sp[7 * 65]);
        *(u32x4*)(WT + (size_t)dest_row(n0 + n, mode) * K + k0 + 8 * c) = o; }
    asm volatile("s_waitcnt lgkmcnt(0)" ::: "memory");
}
__device__ __forceinline__ void convert_part(ldsp lds, const float* W, int K, int N, int Npad, int mode, bf16_t* WT, int gw, int NGW) {
    const int tid = opaque_tid(), lane = tid & 63, wave = rfl(tid >> 6);
    LAS float* scr = (LAS float*)(lds + wave * 16640);
    const int nblk = Npad / 64, nitems = (K / 64) * nblk;
    for (int it = gw; it < nitems; it += NGW) transpose_item(W, K, N, WT, mode, scr, it, nblk, lane);
}
__device__ __forceinline__ void convert_one(ldsp lds, const float* W, int K, int N, int Npad, int mode, bf16_t* WT) {
    const int wave = rfl((int)threadIdx.x >> 6);
    convert_part(lds, W, K, N, Npad, mode, WT, blockIdx.x * 8 + wave, gridDim.x * 8);
}

__device__ __forceinline__ void ln_phase(const float* Y, float* X, bf16_t* Xb, const float* g, const float* b) {
    const int tid = opaque_tid(), lane = tid & 63, wave = rfl(tid >> 6);
    const int gw = blockIdx.x * 8 + wave, NGW = gridDim.x * 8;
    f32x4 gv[8], bv[8];
#pragma unroll
    for (int j = 0; j < 8; ++j) { gv[j] = *(const f32x4*)(g + 4 * lane + 256 * j); bv[j] = *(const f32x4*)(b + 4 * lane + 256 * j); }
    for (int m = gw; m < M; m += NGW) {
        const f32x4* yr = (const f32x4*)(Y + (size_t)m * D) + lane; f32x4 v[8]; float s = 0.f;
#pragma unroll
        for (int j = 0; j < 8; ++j) { v[j] = yr[64 * j]; s += (v[j][0] + v[j][1]) + (v[j][2] + v[j][3]); }
        const float mean = wave_sum(s) * (1.f / D); float s2 = 0.f;
#pragma unroll
        for (int j = 0; j < 8; ++j) { v[j] = v[j] - mean; s2 += (v[j][0] * v[j][0] + v[j][1] * v[j][1]) + (v[j][2] * v[j][2] + v[j][3] * v[j][3]); }
        const float rstd = 1.f / sqrtf(wave_sum(s2) * (1.f / D) + LN_EPS);
        f32x4* xr = (f32x4*)(X + (size_t)m * D) + lane; u32x2* br = (u32x2*)(Xb + (size_t)m * D) + lane;
#pragma unroll
        for (int j = 0; j < 8; ++j) { const f32x4 o = v[j] * rstd * gv[j] + bv[j]; xr[64 * j] = o; u32x2 w; w.x = pk2(o[0], o[1]); w.y = pk2(o[2], o[3]); br[64 * j] = w; }
    }
}

__device__ __forceinline__ void ret_phase(ldsp lds, bf16_t* R) {
    const int tid = opaque_tid(), lane = tid & 63, w = rfl(tid >> 6);
    constexpr int QS = 528, VS = 272, SS = 144;
    ldsp Qs = lds, Ks = lds + 64 * QS, Vs = lds + 128 * QS, Ss = lds + 128 * QS + 64 * VS;
    const int G = gridDim.x, vcu = vcu_of();
    for (int u = vcu; u < 256; u += G) {
        const int b = u >> 5, h = (u >> 2) & 7, vs = u & 3;
        const float l2g = __builtin_log2f(1.f - ex2(-5.f - (float)h));
        const float gC = ex2(l2g * (float)RC);
        f32x4 St[16];
#pragma unroll
        for (int k = 0; k < 16; ++k) St[k] = (f32x4){0.f, 0.f, 0.f, 0.f};
        bf16_t* Rb = R + (size_t)b * T * RETC;
        const int qc = h * 256, kc = 2048 + h * 256, vc = 4096 + h * 512 + vs * 128, vbase = 16 * w;
        u32x4 pq[4], pk[4], pv[2];
#define RET_GLOAD(cc) do { const bf16_t* Rn_ = Rb + (size_t)(RC * (cc)) * RETC; \
            _Pragma("unroll") for (int i = 0; i < 4; ++i) { const int p = tid + 512 * i, r = p >> 5, ch = p & 31; pq[i] = *(const u32x4*)(Rn_ + (size_t)r * RETC + qc + ch * 8); pk[i] = *(const u32x4*)(Rn_ + (size_t)r * RETC + kc + ch * 8); } \
            _Pragma("unroll") for (int i = 0; i < 2; ++i) { const int p = tid + 512 * i, r = p >> 4, ch = p & 15; pv[i] = *(const u32x4*)(Rn_ + (size_t)r * RETC + vc + ch * 8); } } while (0)
        RET_GLOAD(0);
        for (int c = 0; c < T / RC; ++c) {
            bf16_t* Rc = Rb + (size_t)(RC * c) * RETC;
            __syncthreads();
#pragma unroll
            for (int i = 0; i < 4; ++i) { const int p = tid + 512 * i, r = p >> 5, ch = p & 31; *(LAS u32x4*)(Qs + r * QS + ch * 16) = pq[i]; *(LAS u32x4*)(Ks + r * QS + ch * 16) = pk[i]; }
#pragma unroll
            for (int i = 0; i < 2; ++i) { const int p = tid + 512 * i, r = p >> 4, ch = p & 15; *(LAS u32x4*)(Vs + r * VS + ch * 16) = pv[i]; }
            __syncthreads();
            if (c + 1 < T / RC) RET_GLOAD(c + 1);
            int lane_o = lane; asm volatile("" : "+v"(lane_o));
            const int li = lane_o & 15, g4 = lane_o >> 4, tq = li >> 2, tp = li & 3;
            {
                const int nt = w >> 1;
#pragma unroll
                for (int mt2 = 0; mt2 < 2; ++mt2) { const int mt = 2 * (w & 1) + mt2; f32x4 acc = (f32x4){0.f, 0.f, 0.f, 0.f};
                    if (mt <= nt) {
#pragma unroll
                        for (int ks = 0; ks < 8; ++ks) { const bf16x8 a = *(const LAS bf16x8*)(Qs + (16 * nt + li) * QS + (32 * ks + 8 * g4) * 2), bb = *(const LAS bf16x8*)(Ks + (16 * mt + li) * QS + (32 * ks + 8 * g4) * 2); acc = mfma16(a, bb, acc); }
                    }
#pragma unroll
                    for (int i = 0; i < 4; ++i) { const int n = 16 * nt + 4 * g4 + i, mm = 16 * mt + li; const float val = (mm <= n) ? acc[i] * ex2(l2g * (float)(n - (RC - 1))) : 0.f; *(LAS bf16_t*)(Ss + n * SS + mm * 2) = (bf16_t)f2bf(val); }
                }
            }
            __syncthreads();
            bf16x8 vf[2];
#pragma unroll
            for (int ms = 0; ms < 2; ++ms) { const s16x4 lo = trrd(Vs + (32 * ms + 8 * g4 + tq) * VS + (vbase + 4 * tp) * 2), hi = trrd(Vs + (32 * ms + 8 * g4 + 4 + tq) * VS + (vbase + 4 * tp) * 2); vf[ms] = cat8(lo, hi); }
            bf16x8 sb[8];
#pragma unroll
            for (int ks = 0; ks < 8; ++ks) { u32x4 wv; wv.x = pk2(St[2 * ks][0], St[2 * ks][1]); wv.y = pk2(St[2 * ks][2], St[2 * ks][3]); wv.z = pk2(St[2 * ks + 1][0], St[2 * ks + 1][1]); wv.w = pk2(St[2 * ks + 1][2], St[2 * ks + 1][3]); sb[ks] = __builtin_bit_cast(bf16x8, wv); }
#pragma unroll
            for (int nt = 0; nt < 4; ++nt) {
                f32x4 o = (f32x4){0.f, 0.f, 0.f, 0.f}, cr = (f32x4){0.f, 0.f, 0.f, 0.f};
#pragma unroll
                for (int ms = 0; ms < 2; ++ms) if (32 * ms <= 16 * nt + 15) { const bf16x8 a = *(const LAS bf16x8*)(Ss + (16 * nt + li) * SS + (32 * ms + 8 * g4) * 2); o = mfma16(a, vf[ms], o); }
#pragma unroll
                for (int ks = 0; ks < 8; ++ks) { const s16x4 lo = *(const LAS s16x4*)(Qs + (16 * nt + li) * QS + (32 * ks + 4 * g4) * 2), hi = *(const LAS s16x4*)(Qs + (16 * nt + li) * QS + (32 * ks + 16 + 4 * g4) * 2); cr = mfma16(cat8(lo, hi), sb[ks], cr); }
#pragma unroll
                for (int i = 0; i < 4; ++i) { const int n = 16 * nt + 4 * g4 + i; const float val = o[i] + ex2(l2g * (float)(n + 1)) * cr[i]; Rc[(size_t)n * RETC + vc + vbase + li] = (bf16_t)f2bf(val); }
                __builtin_amdgcn_sched_barrier(0);
            }
#pragma unroll
            for (int kt = 0; kt < 16; ++kt) { St[kt] = St[kt] * gC;
#pragma unroll
                for (int ms = 0; ms < 2; ++ms) { const s16x4 lo = trrd(Ks + (32 * ms + 8 * g4 + tq) * QS + (16 * kt + 4 * tp) * 2), hi = trrd(Ks + (32 * ms + 8 * g4 + 4 + tq) * QS + (16 * kt + 4 * tp) * 2); St[kt] = mfma16(cat8(lo, hi), vf[ms], St[kt]); }
                if (kt & 1) __builtin_amdgcn_sched_barrier(0);
            }
        }
    }
#undef RET_GLOAD
    __syncthreads();
}

__device__ __forceinline__ void gn_phase(bf16_t* R, const float* gg, const float* gb) {
    const int tid = opaque_tid(), lane = tid & 63, wave = rfl(tid >> 6);
    const int gw = blockIdx.x * 8 + wave, NGW = gridDim.x * 8;
    for (int it = gw; it < M * 8; it += NGW) {
        const int row = it >> 3, h = it & 7;
        bf16_t* op = R + (size_t)row * RETC + 4096 + h * 512 + 8 * lane; bf16_t* gp = op + 4096;
        const u32x4 ov = *(const u32x4*)op, gv = *(const u32x4*)gp;
        float o[8] = {bflo(ov.x), bfhi(ov.x), bflo(ov.y), bfhi(ov.y), bflo(ov.z), bfhi(ov.z), bflo(ov.w), bfhi(ov.w)};
        float gt[8] = {bflo(gv.x), bfhi(gv.x), bflo(gv.y), bfhi(gv.y), bflo(gv.z), bfhi(gv.z), bflo(gv.w), bfhi(gv.w)};
        float s = 0.f;
#pragma unroll
        for (int i = 0; i < 8; ++i) s += o[i];
        const float mean = wave_sum(s) * (1.f / 512.f); float s2 = 0.f;
#pragma unroll
        for (int i = 0; i < 8; ++i) { o[i] -= mean; s2 += o[i] * o[i]; }
        const float rstd = 1.f / sqrtf(wave_sum(s2) * (1.f / 512.f) + LN_EPS);
        const f32x4 g0 = *(const f32x4*)(gg + h * 512 + 8 * lane), g1 = *(const f32x4*)(gg + h * 512 + 8 * lane + 4), b0 = *(const f32x4*)(gb + h * 512 + 8 * lane), b1 = *(const f32x4*)(gb + h * 512 + 8 * lane + 4);
        float y[8];
#pragma unroll
        for (int i = 0; i < 8; ++i) { const float gi = i < 4 ? g0[i & 3] : g1[i & 3], bi = i < 4 ? b0[i & 3] : b1[i & 3]; y[i] = siluf(gt[i]) * (o[i] * rstd * gi + bi); }
        u32x4 w; w.x = pk2(y[0], y[1]); w.y = pk2(y[2], y[3]); w.z = pk2(y[4], y[5]); w.w = pk2(y[6], y[7]); *(u32x4*)gp = w;
    }
}

__device__ __forceinline__ void cmp_gather_phase(const bf16_t* KV, const float* cmp_pos, bf16_t* A) {
    const size_t gt = (size_t)blockIdx.x * 512 + threadIdx.x, NT = (size_t)gridDim.x * 512;
    for (size_t p = gt; p < (size_t)2 * 4096 * 512; p += NT) {
        const int dch = (int)(p & 15), l = (int)((p >> 4) & 31), Rr = (int)((p >> 9) & 4095), c = (int)(p >> 21);
        const int n = Rr & 127, bg = Rr >> 7, b = bg >> 2, g = bg & 3;
        u32x4 w = (u32x4){0u, 0u, 0u, 0u};
        if (n < 127) {
            const u32x4 kv = *(const u32x4*)(KV + (size_t)(b * T + 16 * n + l) * KVC + c * 512 + g * 128 + dch * 8);
            const float* pp = cmp_pos + (c * 32 + l) * 128 + dch * 8; const f32x4 p0 = *(const f32x4*)pp, p1 = *(const f32x4*)(pp + 4);
            w.x = pk2(bflo(kv.x) + p0[0], bfhi(kv.x) + p0[1]); w.y = pk2(bflo(kv.y) + p0[2], bfhi(kv.y) + p0[3]); w.z = pk2(bflo(kv.z) + p1[0], bfhi(kv.z) + p1[1]); w.w = pk2(bflo(kv.w) + p1[2], bfhi(kv.w) + p1[3]);
        }
        *(u32x4*)(A + ((size_t)c * 4096 + Rr) * 4096 + l * 128 + dch * 8) = w;
    }
}
__device__ __forceinline__ void cmp2_phase(const bf16_t* Hc, const float* W2, const float* ncos, const float* nsin, bf16_t* Kc, bf16_t* Vc) {
    const int gt = blockIdx.x * 512 + threadIdx.x, NT = gridDim.x * 512;
    for (int p = gt; p < 2 * 4096 * 16; p += NT) {
        const int dq = p & 15, Rr = (p >> 4) & 4095, c = p >> 16;
        const bf16_t* hr = Hc + ((size_t)c * 4096 + Rr) * 512; const float* w2 = W2 + (size_t)c * 512 * 128 + dq;
        float acc[8];
#pragma unroll
        for (int i = 0; i < 8; ++i) acc[i] = 0.f;
        for (int e0 = 0; e0 < 512; e0 += 8) {
            const u32x4 hv = *(const u32x4*)(hr + e0);
            const float hh[8] = {bflo(hv.x), bfhi(hv.x), bflo(hv.y), bfhi(hv.y), bflo(hv.z), bfhi(hv.z), bflo(hv.w), bfhi(hv.w)};
#pragma unroll
            for (int e = 0; e < 8; ++e)
#pragma unroll
                for (int i = 0; i < 8; ++i) acc[i] += hh[e] * w2[(size_t)(e0 + e) * 128 + 16 * i];
        }
        const int n = Rr & 127;
        if (c == 0) { const int pos = (16 * n + 31) & (T - 1); const float cs = ncos[pos * 16 + dq], sn = nsin[pos * 16 + dq]; const float x1 = acc[0], x2 = acc[1]; acc[0] = x1 * cs - x2 * sn; acc[1] = x2 * cs + x1 * sn; }
        bf16_t* o = (c == 0 ? Kc : Vc) + (size_t)Rr * 128 + dq;
#pragma unroll
        for (int i = 0; i < 8; ++i) o[16 * i] = (bf16_t)f2bf(acc[i]);
    }
}

constexpr int KSTR = 272;
__device__ __forceinline__ void load_tile64(ldsp dst, const bf16_t* src, int ld, int tid) {
#pragma unroll
    for (int i = 0; i < 2; ++i) { const int p = tid + 512 * i, r = p >> 4, ch = p & 15; const u32x4 v = *(const u32x4*)(src + (size_t)r * ld + ch * 8); *(LAS u32x4*)(dst + r * KSTR + ch * 16) = v; }
}
struct TileRegs { u32x4 k0, k1, v0, v1; };
__device__ __forceinline__ void tile_gload(TileRegs& r, const bf16_t* kp, const bf16_t* vp, int ld, int tid) {
    const int p0 = tid, p1 = tid + 512;
    r.k0 = *(const u32x4*)(kp + (size_t)(p0 >> 4) * ld + (p0 & 15) * 8); r.k1 = *(const u32x4*)(kp + (size_t)(p1 >> 4) * ld + (p1 & 15) * 8);
    r.v0 = *(const u32x4*)(vp + (size_t)(p0 >> 4) * ld + (p0 & 15) * 8); r.v1 = *(const u32x4*)(vp + (size_t)(p1 >> 4) * ld + (p1 & 15) * 8);
}
__device__ __forceinline__ void tile_lstore(ldsp Kt, ldsp Vt, const TileRegs& r, int tid) {
    const int p0 = tid, p1 = tid + 512;
    *(LAS u32x4*)(Kt + (p0 >> 4) * KSTR + (p0 & 15) * 16) = r.k0; *(LAS u32x4*)(Kt + (p1 >> 4) * KSTR + (p1 & 15) * 16) = r.k1;
    *(LAS u32x4*)(Vt + (p0 >> 4) * KSTR + (p0 & 15) * 16) = r.v0; *(LAS u32x4*)(Vt + (p1 >> 4) * KSTR + (p1 & 15) * 16) = r.v1;
}
__device__ __forceinline__ void attn_step(ldsp Kt, ldsp Vt, const bf16x8 (&qf)[8], float& mrow, float& lrow, f32x16 (&Oc)[4], int kp0, int t, int lo, bool en, int ql, int h5, int lane) {
    if (__builtin_amdgcn_ballot_w64(en) == 0ull) return;
    f32x16 s[2];
#pragma unroll
    for (int kb = 0; kb < 2; ++kb) { s[kb] = (f32x16){};
#pragma unroll
        for (int ks = 0; ks < 8; ++ks) { const bf16x8 a = *(const LAS bf16x8*)(Kt + (32 * kb + ql) * KSTR + (16 * ks + 8 * h5) * 2); s[kb] = mfma32(a, qf[ks], s[kb]); }
        __builtin_amdgcn_sched_barrier(0); }
    float mx = -1e30f;
    const int hiL = t - kp0 - 4 * h5, loL = lo - kp0 - 4 * h5;
#pragma unroll
    for (int kb = 0; kb < 2; ++kb)
#pragma unroll
        for (int r = 0; r < 16; ++r) { const int cr = 32 * kb + (r & 3) + 8 * (r >> 2); const bool v = en && cr <= hiL && cr > loL; s[kb][r] = v ? s[kb][r] : -1e30f; mx = fmaxf(mx, s[kb][r]); }
    mx = fmaxf(mx, __shfl_xor(mx, 32));
    const float mnew = fmaxf(mrow, mx), al = ex2(mrow - mnew); mrow = mnew;
    float ps = 0.f;
#pragma unroll
    for (int kb = 0; kb < 2; ++kb)
#pragma unroll
        for (int r = 0; r < 16; ++r) { const float p = s[kb][r] > -1e29f ? ex2(s[kb][r] - mnew) : 0.f; s[kb][r] = p; ps += p; }
    lrow = lrow * al + ps;
#pragma unroll
    for (int d = 0; d < 4; ++d) Oc[d] = Oc[d] * al;
    const int li = lane & 15, tq = li >> 2, tp = li & 3, gi = (lane >> 4) & 1;
#pragma unroll
    for (int kb = 0; kb < 2; ++kb)
#pragma unroll
        for (int sx = 0; sx < 2; ++sx) {
            u32x4 pw; pw.x = pk2(s[kb][8 * sx + 0], s[kb][8 * sx + 1]); pw.y = pk2(s[kb][8 * sx + 2], s[kb][8 * sx + 3]); pw.z = pk2(s[kb][8 * sx + 4], s[kb][8 * sx + 5]); pw.w = pk2(s[kb][8 * sx + 6], s[kb][8 * sx + 7]);
            const bf16x8 pf = __builtin_bit_cast(bf16x8, pw);
            const int kbase = 32 * kb + 16 * sx + 4 * h5;
#pragma unroll
            for (int d = 0; d < 4; ++d) { const int cb = 32 * d + 16 * gi + 4 * tp;
                const s16x4 lo4 = trrd(Vt + (kbase + tq) * KSTR + cb * 2), hi4 = trrd(Vt + (kbase + 8 + tq) * KSTR + cb * 2);
                Oc[d] = mfma32(cat8(lo4, hi4), pf, Oc[d]); }
            __builtin_amdgcn_sched_barrier(0);
        }
}

__device__ __forceinline__ void nsa_phase(ldsp lds, const bf16_t* Qn, const bf16_t* KV, const bf16_t* Kc, const bf16_t* Vc, bf16_t* O) {
    const int tid = opaque_tid(), lane = tid & 63, w = rfl(tid >> 6), ql = lane & 31, h5 = lane >> 5;
    ldsp Kt = lds, Vt = lds + 128 * KSTR; LAS float* PS = (LAS float*)(lds + 256 * KSTR); LAS unsigned* SEL = (LAS unsigned*)(lds + 256 * KSTR + 32768); LAS unsigned* UNI = SEL + 64;
    const int G = gridDim.x, vcu = vcu_of();
    const int hh = w >> 1, th = w & 1, tqi = 32 * th + ql;
    for (int uu = vcu; uu < 1024; uu += G) {
        const int v8 = uu % 256, rnd = uu / 256; const int bg = v8 >> 3, s8 = v8 & 7; const int qb = rnd == 0 ? s8 : rnd == 1 ? 15 - s8 : rnd == 2 ? 16 + s8 : 31 - s8;
        const int b = bg >> 2, g = bg & 3;
        const int t = 64 * qb + tqi; const size_t row = (size_t)b * T + t;
        const bf16_t* qp = Qn + row * NQC + (4 * g + hh) * 128;
        bf16x8 qf[8];
#pragma unroll
        for (int ks = 0; ks < 8; ++ks) qf[ks] = *(const bf16x8*)(qp + 16 * ks + 8 * h5);
        float gate[3];
#pragma unroll
        for (int i = 0; i < 3; ++i) gate[i] = sigmf(bf2f(Qn[row * NQC + 2048 + (4 * g + hh) * 3 + i]));
        unsigned Oa[4][8];
        __syncthreads();
        load_tile64(Kt, Kc + (size_t)bg * 128 * 128, 128, tid); load_tile64(Kt + 64 * KSTR, Kc + (size_t)bg * 128 * 128 + 64 * 128, 128, tid);
        load_tile64(Vt, Vc + (size_t)bg * 128 * 128, 128, tid); load_tile64(Vt + 64 * KSTR, Vc + (size_t)bg * 128 * 128 + 64 * 128, 128, tid);
        if (tid == 0) UNI[0] = 0u;
        __syncthreads();
        {
            f32x16 s[4]; float mx = -1e30f;
            const int nlim = min(126, (t - 31) >> 4) - 4 * h5;
#pragma unroll
            for (int kb = 0; kb < 4; ++kb) { s[kb] = (f32x16){};
#pragma unroll
                for (int ks = 0; ks < 8; ++ks) { const bf16x8 a = *(const LAS bf16x8*)(Kt + (32 * kb + ql) * KSTR + (16 * ks + 8 * h5) * 2); s[kb] = mfma32(a, qf[ks], s[kb]); }
#pragma unroll
                for (int r = 0; r < 16; ++r) { const int cn = 32 * kb + (r & 3) + 8 * (r >> 2); const bool v = cn <= nlim; s[kb][r] = v ? s[kb][r] : -1e30f; mx = fmaxf(mx, s[kb][r]); } }
            mx = fmaxf(mx, __shfl_xor(mx, 32));
            float ps = 0.f;
#pragma unroll
            for (int kb = 0; kb < 4; ++kb)
#pragma unroll
                for (int r = 0; r < 16; ++r) { const float p = s[kb][r] > -1e29f ? ex2(s[kb][r] - mx) : 0.f; s[kb][r] = p; ps += p; }
            ps += __shfl_xor(ps, 32);
            const float inv = ps > 0.f ? 1.f / ps : 0.f;
            float Gs[16], Es[16];
#pragma unroll
            for (int kb = 0; kb < 4; ++kb)
#pragma unroll
                for (int rr = 0; rr < 4; ++rr) { float a0 = s[kb][4 * rr] * inv, a1 = s[kb][4 * rr + 1] * inv, a2 = s[kb][4 * rr + 2] * inv, a3 = s[kb][4 * rr + 3] * inv;
                    s[kb][4 * rr] = a0; s[kb][4 * rr + 1] = a1; s[kb][4 * rr + 2] = a2; s[kb][4 * rr + 3] = a3; Gs[kb * 4 + rr] = (a0 + a1) + (a2 + a3); Es[kb * 4 + rr] = a3; }
            float prevE = 0.f;
#pragma unroll
            for (int idx = 0; idx < 16; ++idx) { const float ep = __shfl_xor(Es[idx], 32); const float val = Gs[idx] + (h5 ? ep : prevE); prevE = ep;
                const int j = 8 * (idx >> 2) + 2 * (idx & 3) + h5; PS[(hh * 64 + tqi) * 32 + j] = val; }
            f32x16 Oc[4];
#pragma unroll
            for (int d = 0; d < 4; ++d) Oc[d] = (f32x16){};
            const int li = lane & 15, tq = li >> 2, tp = li & 3, gi = (lane >> 4) & 1;
#pragma unroll
            for (int kb = 0; kb < 4; ++kb)
#pragma unroll
                for (int sx = 0; sx < 2; ++sx) {
                    u32x4 pw; pw.x = pk2(s[kb][8 * sx + 0], s[kb][8 * sx + 1]); pw.y = pk2(s[kb][8 * sx + 2], s[kb][8 * sx + 3]); pw.z = pk2(s[kb][8 * sx + 4], s[kb][8 * sx + 5]); pw.w = pk2(s[kb][8 * sx + 6], s[kb][8 * sx + 7]);
                    const bf16x8 pf = __builtin_bit_cast(bf16x8, pw); const int kbase = 32 * kb + 16 * sx + 4 * h5;
#pragma unroll
                    for (int d = 0; d < 4; ++d) { const int cb = 32 * d + 16 * gi + 4 * tp;
                        const s16x4 lo4 = trrd(Vt + (kbase + tq) * KSTR + cb * 2), hi4 = trrd(Vt + (kbase + 8 + tq) * KSTR + cb * 2);
                        Oc[d] = mfma32(cat8(lo4, hi4), pf, Oc[d]); }
                    __builtin_amdgcn_sched_barrier(0);
                }
#pragma unroll
            for (int d = 0; d < 4; ++d)
#pragma unroll
                for (int r = 0; r < 8; ++r) Oa[d][r] = pk2(Oc[d][2 * r] * gate[0], Oc[d][2 * r + 1] * gate[0]);
        }
        __syncthreads();
        if (tid < 64) {
            float sc[32];
#pragma unroll
            for (int j = 0; j < 32; ++j) sc[j] = (PS[(0 * 64 + tid) * 32 + j] + PS[(1 * 64 + tid) * 32 + j]) + (PS[(2 * 64 + tid) * 32 + j] + PS[(3 * 64 + tid) * 32 + j]);
            const int cur = qb; unsigned sel = 1u | (1u << cur) | (cur > 0 ? (1u << (cur - 1)) : 0u);
            const int need = 8 - __builtin_popcount(sel);
#pragma unroll
            for (int it = 0; it < 5; ++it) if (it < need) { float best = -1.f; int bj = -1;
#pragma unroll
                for (int j = 1; j < 32; ++j) { const bool ok = (j <= cur - 2) && !((sel >> j) & 1u); if (ok && sc[j] > best) { best = sc[j]; bj = j; } }
                if (bj >= 0) sel |= 1u << bj; }
            SEL[tid] = sel; atomicOr((unsigned*)UNI, sel);
        }
        __syncthreads();
        const unsigned mysel = SEL[tqi], uni = UNI[0];
        {
            float mrow = -1e30f, lrow = 0.f; f32x16 Oc[4];
#pragma unroll
            for (int d = 0; d < 4; ++d) Oc[d] = (f32x16){};
            const bf16_t* kvb = KV + (size_t)b * T * KVC + g * 128;
            unsigned rem = uni & (0xffffffffu >> (31 - qb));
            int j = __builtin_ctz(rem); rem &= rem - 1u;
            TileRegs tr; tile_gload(tr, kvb + (size_t)(64 * j) * KVC + 2 * 512, kvb + (size_t)(64 * j) * KVC + 3 * 512, KVC, tid);
            for (;;) {
                __syncthreads();
                tile_lstore(Kt, Vt, tr, tid);
                __syncthreads();
                int jn = -1;
                if (rem) { jn = __builtin_ctz(rem); rem &= rem - 1u; tile_gload(tr, kvb + (size_t)(64 * jn) * KVC + 2 * 512, kvb + (size_t)(64 * jn) * KVC + 3 * 512, KVC, tid); }
                attn_step(Kt, Vt, qf, mrow, lrow, Oc, 64 * j, t, -1, ((mysel >> j) & 1u) != 0u, ql, h5, lane);
                if (jn < 0) break;
                j = jn;
            }
            lrow += __shfl_xor(lrow, 32); const float sc = gate[1] / lrow;
#pragma unroll
            for (int d = 0; d < 4; ++d)
#pragma unroll
                for (int r = 0; r < 8; ++r) Oa[d][r] = pk2(bflo(Oa[d][r]) + Oc[d][2 * r] * sc, bfhi(Oa[d][r]) + Oc[d][2 * r + 1] * sc);
        }
        {
            float mrow = -1e30f, lrow = 0.f; f32x16 Oc[4];
#pragma unroll
            for (int d = 0; d < 4; ++d) Oc[d] = (f32x16){};
            const bf16_t* kvb = KV + (size_t)b * T * KVC + g * 128;
            int j = (qb > 8 ? qb - 8 : 0);
            TileRegs tr; tile_gload(tr, kvb + (size_t)(64 * j) * KVC + 4 * 512, kvb + (size_t)(64 * j) * KVC + 5 * 512, KVC, tid);
            for (;;) {
                __syncthreads();
                tile_lstore(Kt, Vt, tr, tid);
                __syncthreads();
                const int jn = j + 1;
                if (jn <= qb) tile_gload(tr, kvb + (size_t)(64 * jn) * KVC + 4 * 512, kvb + (size_t)(64 * jn) * KVC + 5 * 512, KVC, tid);
                attn_step(Kt, Vt, qf, mrow, lrow, Oc, 64 * j, t, t - 512, true, ql, h5, lane);
                if (jn > qb) break;
                j = jn;
            }
            lrow += __shfl_xor(lrow, 32); const float sc = gate[2] / lrow;
            bf16_t* op = O + row * D + (4 * g + hh) * 128 + 4 * h5;
#pragma unroll
            for (int d = 0; d < 4; ++d)
#pragma unroll
                for (int rr = 0; rr < 4; ++rr) { u32x2 wv;
                    wv.x = pk2(bflo(Oa[d][2 * rr]) + Oc[d][4 * rr] * sc, bfhi(Oa[d][2 * rr]) + Oc[d][4 * rr + 1] * sc);
                    wv.y = pk2(bflo(Oa[d][2 * rr + 1]) + Oc[d][4 * rr + 2] * sc, bfhi(Oa[d][2 * rr + 1]) + Oc[d][4 * rr + 3] * sc);
                    *(u32x2*)(op + 32 * d + 8 * rr) = wv; }
        }
    }
    __syncthreads();
}

#ifndef COSF
#define COSF cosf
#define SINF sinf
#endif
#ifndef GMASK
#define GMASK 0xffff
#endif
constexpr int NPHASE = 26;
typedef const __attribute__((address_space(4))) Params* cparams_t;
__device__ __forceinline__ cparams_t kparams() { const __attribute__((address_space(4))) void* q = (const __attribute__((address_space(4))) void*)__builtin_amdgcn_kernarg_segment_ptr(); asm volatile("" : "+s"(q)); return (cparams_t)q; }
#define PHASE_BEGIN if (lo <= ph && ph < hi) { cparams_t pp = kparams(); unsigned char* ws = pp->ws; bf16_t* Xb = (bf16_t*)(ws + WS_XB); bf16_t* KVb = (bf16_t*)(ws + WS_KV); bf16_t* R = (bf16_t*)(ws + WS_R); bf16_t* Hb = (bf16_t*)(ws + WS_R + R_H); \
    float* rcos = (float*)(ws + WS_ROPE_R); float* rsin = rcos + 2048 * 128; float* ncos = (float*)(ws + WS_ROPE_N); float* nsin = ncos + 2048 * 16; (void)Xb; (void)KVb; (void)R; (void)Hb; (void)rcos; (void)rsin; (void)ncos; (void)nsin;
#define PHASE_END } if (lo <= ph && ph + 1 < hi) grid.sync(); ++ph;

template <int layer> __device__ __forceinline__ void run_layer(ldsp lds, cg::grid_group& grid, const int lo, const int hi, int& ph, const int G) {
        PHASE_BEGIN
            pg8::Gemm g{Xb, (const bf16_t*)(ws + W_FFN1_IN), M, 2 * FF, D, D}; pg8::StaticOrder S; S.init(M, 2 * FF, G, (int)blockIdx.x);
            pg8::Epi<pg8::EPI_SWIGLU> E{Hb, nullptr, FF, 0.f, 0.f, nullptr, nullptr};
            if (GMASK & (1 << 0)) pg8::gemm_phase(lds, g, S, E);
        PHASE_END
        PHASE_BEGIN
            pg8::Gemm g{Hb, (const bf16_t*)(ws + W_FFN1_OUT), M, D, FF, FF}; pg8::LnOrder S{vcu_of()};
            pg8::EpiLN E{pp->out, layer == 0 ? pp->x : pp->out, Xb, pp->ln_g + (layer * 3 + 0) * D, pp->ln_b + (layer * 3 + 0) * D, ALPHA, 0.5f, (unsigned long long*)(ws + WS_XBUF), (unsigned*)(ws + WS_CNT) + (layer * 3 + 0) * 4096, lds + 131072, G == 256 ? 1 : 0};
            pg8::gemm_phase(lds, g, S, E);
        PHASE_END
        if constexpr (layer == 0) {
            PHASE_BEGIN
                pg8::Gemm g{Xb, (const bf16_t*)(ws + W_RET_IN), M, RETC, D, D}; pg8::StaticOrder S; S.init(M, RETC, G, (int)blockIdx.x);
                pg8::Epi<pg8::EPI_RET> E{R, nullptr, RETC, 0.f, 0.f, rcos, rsin};
                if (GMASK & (1 << 2)) pg8::gemm_phase(lds, g, S, E);
            PHASE_END
            PHASE_BEGIN
#ifndef SKIP_RET
                ret_phase(lds, R);
#endif
            PHASE_END
            PHASE_BEGIN
                gn_phase(R, pp->gn_g, pp->gn_b);
            PHASE_END
            PHASE_BEGIN
                pg8::Gemm g{R + 8192, (const bf16_t*)(ws + W_RET_OUT), M, D, 4096, RETC}; pg8::LnOrder S{vcu_of()};
            pg8::EpiLN E{pp->out, pp->out, Xb, pp->ln_g + (layer * 3 + 1) * D, pp->ln_b + (layer * 3 + 1) * D, ALPHA, 1.0f, (unsigned long long*)(ws + WS_XBUF), (unsigned*)(ws + WS_CNT) + (layer * 3 + 1) * 4096, lds + 131072, G == 256 ? 1 : 0};
            pg8::gemm_phase(lds, g, S, E);
            PHASE_END
        } else {
            PHASE_BEGIN
                pg8::Gemm g{Xb, (const bf16_t*)(ws + W_NSA_Q), M, NQC, D, D}; pg8::StaticOrder S; S.init(M, NQC, G, (int)blockIdx.x);
                pg8::Epi<pg8::EPI_NSAQ> E{(bf16_t*)(ws + WS_R + R_QN), nullptr, NQC, QSCALE, 0.f, ncos, nsin};
                if (GMASK & (1 << 4)) pg8::gemm_phase(lds, g, S, E);
            PHASE_END
            PHASE_BEGIN
#ifndef SKIP_NSA
                nsa_phase(lds, (const bf16_t*)(ws + WS_R + R_QN), KVb, (const bf16_t*)(ws + WS_KC), (const bf16_t*)(ws + WS_VC), (bf16_t*)(ws + WS_R + R_O));
#endif
            PHASE_END
            PHASE_BEGIN
                pg8::Gemm g{(const bf16_t*)(ws + WS_R + R_O), (const bf16_t*)(ws + W_NSA_OUT), M, D, D, D}; pg8::LnOrder S{vcu_of()};
            pg8::EpiLN E{pp->out, pp->out, Xb, pp->ln_g + (layer * 3 + 1) * D, pp->ln_b + (layer * 3 + 1) * D, ALPHA, 1.0f, (unsigned long long*)(ws + WS_XBUF), (unsigned*)(ws + WS_CNT) + (layer * 3 + 1) * 4096, lds + 131072, G == 256 ? 1 : 0};
            pg8::gemm_phase(lds, g, S, E);
            PHASE_END
        }
        PHASE_BEGIN
            pg8::Gemm g{Xb, (const bf16_t*)(ws + W_FFN2_IN), M, 2 * FF, D, D}; pg8::StaticOrder S; S.init(M, 2 * FF, G, (int)blockIdx.x);
            pg8::Epi<pg8::EPI_SWIGLU> E{Hb, nullptr, FF, 0.f, 0.f, nullptr, nullptr};
            if (GMASK & (1 << 6)) pg8::gemm_phase(lds, g, S, E);
        PHASE_END
        PHASE_BEGIN
            pg8::Gemm g{Hb, (const bf16_t*)(ws + W_FFN2_OUT), M, D, FF, FF}; pg8::LnOrder S{vcu_of()};
            pg8::EpiLN E{pp->out, pp->out, Xb, pp->ln_g + (layer * 3 + 2) * D, pp->ln_b + (layer * 3 + 2) * D, ALPHA, 0.5f, (unsigned long long*)(ws + WS_XBUF), (unsigned*)(ws + WS_CNT) + (layer * 3 + 2) * 4096, lds + 131072, G == 256 ? 1 : 0};
            pg8::gemm_phase(lds, g, S, E);
        PHASE_END
        if constexpr (layer == 0) {
            PHASE_BEGIN
                pg8::Gemm g{Xb, (const bf16_t*)(ws + W_KV), M, KVC, D, D}; pg8::StaticOrder S; S.init(M, KVC, G, (int)blockIdx.x);
                pg8::Epi<pg8::EPI_KV> E{KVb, nullptr, KVC, 1.f, 0.f, ncos, nsin};
                if (GMASK & (1 << 8)) pg8::gemm_phase(lds, g, S, E);
            PHASE_END
            PHASE_BEGIN
                cmp_gather_phase(KVb, pp->cmp_pos, (bf16_t*)(ws + WS_R + R_ACMP));
            PHASE_END
            PHASE_BEGIN
                if (blockIdx.x < 64) {
                pg8::Gemm g{(const bf16_t*)(ws + WS_R + R_ACMP), (const bf16_t*)(ws + W_CMP1), 8192, 1024, 4096, 4096}; pg8::CmpOrder S{G, (int)blockIdx.x};
                pg8::Epi<pg8::EPI_CMP1> E{(bf16_t*)(ws + WS_R + R_HC), pp->cmp_b1, 512, 0.f, 0.f, nullptr, nullptr};
                pg8::gemm_phase(lds, g, S, E);
                } else {
                const int gw = ((int)blockIdx.x - 64) * 8 + rfl((int)threadIdx.x >> 6), NGW = (G - 64) * 8;
                convert_part(lds, pp->ffn1_in + (size_t)D * 2 * FF, D, 2 * FF, 2 * FF, 1, (bf16_t*)(ws + W_FFN1_IN), gw, NGW);
                convert_part(lds, pp->ffn1_out + (size_t)FF * D, FF, D, D, 0, (bf16_t*)(ws + W_FFN1_OUT), gw, NGW);
                convert_part(lds, pp->ffn2_in + (size_t)D * 2 * FF, D, 2 * FF, 2 * FF, 1, (bf16_t*)(ws + W_FFN2_IN), gw, NGW);
                convert_part(lds, pp->ffn2_out + (size_t)FF * D, FF, D, D, 0, (bf16_t*)(ws + W_FFN2_OUT), gw, NGW);
                convert_part(lds, pp->nsa_q, D, 2096, NQC, 0, (bf16_t*)(ws + W_NSA_Q), gw, NGW);
                convert_part(lds, pp->nsa_out, D, D, D, 0, (bf16_t*)(ws + W_NSA_OUT), gw, NGW);
                }
            PHASE_END
            PHASE_BEGIN
                cmp2_phase((const bf16_t*)(ws + WS_R + R_HC), pp->cmp_w2, ncos, nsin, (bf16_t*)(ws + WS_KC), (bf16_t*)(ws + WS_VC));
            PHASE_END
        }
    }

__global__ void __launch_bounds__(512, 2) yoco_fwd(Params p) {
    extern __shared__ __attribute__((aligned(16))) unsigned char lds_raw[];
    ldsp lds = (ldsp)lds_raw;
    cg::grid_group grid = cg::this_grid();
    const int G = gridDim.x;
    const int lo = p.ph_lo, hi = p.ph_hi;
    int ph = 0;
    PHASE_BEGIN
        convert_one(lds, pp->ffn1_in, D, 2 * FF, 2 * FF, 1, (bf16_t*)(ws + W_FFN1_IN));
        convert_one(lds, pp->ffn1_out, FF, D, D, 0, (bf16_t*)(ws + W_FFN1_OUT));
        convert_one(lds, pp->ffn2_in, D, 2 * FF, 2 * FF, 1, (bf16_t*)(ws + W_FFN2_IN));
        convert_one(lds, pp->ffn2_out, FF, D, D, 0, (bf16_t*)(ws + W_FFN2_OUT));
        convert_one(lds, pp->ret_in, D, RETC, RETC, 0, (bf16_t*)(ws + W_RET_IN));
        convert_one(lds, pp->ret_out, 4096, D, D, 0, (bf16_t*)(ws + W_RET_OUT));
        convert_one(lds, pp->kv_w, D, KVC, KVC, 0, (bf16_t*)(ws + W_KV));
        convert_one(lds, pp->cmp_w1, 4096, 512, 512, 0, (bf16_t*)(ws + W_CMP1));
        convert_one(lds, pp->cmp_w1 + (size_t)4096 * 512, 4096, 512, 512, 0, (bf16_t*)(ws + W_CMP1) + (size_t)512 * 4096);
        const size_t gt = (size_t)blockIdx.x * 512 + threadIdx.x, NT = (size_t)G * 512;
        for (size_t i = gt; i < (size_t)6 * 4096; i += NT) ((unsigned*)(ws + WS_CNT))[i] = 0u;
        for (size_t i = gt; i < (size_t)2048 * 128; i += NT) { const int pos = (int)(i >> 7), f = (int)(i & 127); const float inv = powf(10000.f, -(float)f / 128.f); const float ang = (float)pos * inv; rcos[i] = COSF(ang); rsin[i] = SINF(ang); }
        for (size_t i = gt; i < (size_t)2048 * 16; i += NT) { const int pos = (int)(i >> 4), f = (int)(i & 15); const float inv = powf(500000.f, -(float)f / 16.f); const float ang = (float)pos * inv; ncos[i] = COSF(ang); nsin[i] = SINF(ang); }
        for (size_t i = gt; i < (size_t)M * D / 8; i += NT) { const f32x4 a = *(const f32x4*)(pp->x + i * 8), b2 = *(const f32x4*)(pp->x + i * 8 + 4); u32x4 w; w.x = pk2(a[0], a[1]); w.y = pk2(a[2], a[3]); w.z = pk2(b2[0], b2[1]); w.w = pk2(b2[2], b2[3]); *(u32x4*)(Xb + i * 8) = w; }
    PHASE_END

    run_layer<0>(lds, grid, lo, hi, ph, G);
    run_layer<1>(lds, grid, lo, hi, ph, G);
#undef PHASE_BEGIN
#undef PHASE_END
}

#ifndef N_LAUNCH_MODE
#define N_LAUNCH_MODE 1
#endif
extern "C" void kernel_launch(void* const* d_in, const int* in_sizes, int n_in, void* d_out, int out_size, void* d_ws, size_t ws_size, hipStream_t stream) {
    static int inited = 0;
    if (!inited) { (void)hipFuncSetAttribute((const void*)yoco_fwd, hipFuncAttributeMaxDynamicSharedMemorySize, LDS_BYTES); inited = 1; }
    Params p{};
    p.x = (const float*)d_in[0]; p.ln_g = (const float*)d_in[1]; p.ln_b = (const float*)d_in[2];
    p.ffn1_in = (const float*)d_in[3]; p.ffn1_out = (const float*)d_in[4]; p.ffn2_in = (const float*)d_in[5]; p.ffn2_out = (const float*)d_in[6];
    p.ret_in = (const float*)d_in[7]; p.gn_g = (const float*)d_in[8]; p.gn_b = (const float*)d_in[9]; p.ret_out = (const float*)d_in[10];
    p.kv_w = (const float*)d_in[11]; p.cmp_pos = (const float*)d_in[12]; p.cmp_w1 = (const float*)d_in[13]; p.cmp_b1 = (const float*)d_in[14]; p.cmp_w2 = (const float*)d_in[15];
    p.nsa_q = (const float*)d_in[16]; p.nsa_out = (const float*)d_in[17];
    p.out = (float*)d_out; p.ws = (unsigned char*)d_ws;
#if N_LAUNCH_MODE == 1
    p.ph_lo = 0; p.ph_hi = 64;
    void* args[] = {&p};
    hipError_t e = hipLaunchCooperativeKernel((const void*)yoco_fwd, dim3(256), dim3(512), args, LDS_BYTES, stream);
    if (e != hipSuccess) fprintf(stderr, "cooperative launch failed: %s\n", hipGetErrorString(e));
#else
    for (int ph = 0; ph < 32; ++ph) { p.ph_lo = ph; p.ph_hi = ph + 1; hipLaunchKernelGGL(yoco_fwd, dim3(256), dim3(512), LDS_BYTES, stream, p); }
#endif
}
```

```cpp
#include <hip/hip_runtime.h>
#include <hip/hip_cooperative_groups.h>
#include <cstdint>
#include <cstdio>
namespace cg = cooperative_groups;

#define LAS __attribute__((address_space(3)))
typedef unsigned short bf16_t;
typedef short bf16x8 __attribute__((ext_vector_type(8)));
typedef short s16x4 __attribute__((ext_vector_type(4)));
typedef float f32x4 __attribute__((ext_vector_type(4)));
typedef float f32x16 __attribute__((ext_vector_type(16)));
typedef unsigned u32x4 __attribute__((ext_vector_type(4)));
typedef unsigned u32x2 __attribute__((ext_vector_type(2)));
typedef LAS unsigned char* ldsp;

constexpr int BATCH = 8, T = 2048, D = 2048, M = BATCH * T, FF = 5632;
constexpr int RETC = 12288;
constexpr int KVC = 3072, NQC = 2304;
constexpr float ALPHA = 1.41421356237f, LN_EPS = 1e-5f;
constexpr float QSCALE = 0.08838834764831845f * 1.4426950408889634f;
constexpr int RC = 64;

constexpr size_t MiB = 1u << 20;
constexpr size_t W_FFN1_IN = 0;
constexpr size_t W_FFN1_OUT = W_FFN1_IN + (size_t)2 * FF * D * 2;
constexpr size_t W_FFN2_IN = W_FFN1_OUT + (size_t)D * FF * 2;
constexpr size_t W_FFN2_OUT = W_FFN2_IN + (size_t)2 * FF * D * 2;
constexpr size_t W_X0 = W_FFN2_OUT + (size_t)D * FF * 2;
constexpr size_t W_RET_IN = W_X0;
constexpr size_t W_RET_OUT = W_RET_IN + (size_t)RETC * D * 2;
constexpr size_t W_KV = W_RET_OUT + (size_t)D * 4096 * 2;
constexpr size_t W_CMP1 = W_KV + (size_t)KVC * D * 2;
constexpr size_t W_END0 = W_CMP1 + (size_t)1024 * 4096 * 2;
constexpr size_t W_NSA_Q = W_X0;
constexpr size_t W_NSA_OUT = W_NSA_Q + (size_t)NQC * D * 2;
constexpr size_t WS_XB = 216 * MiB;
constexpr size_t WS_KV = 280 * MiB;
constexpr size_t WS_R = 376 * MiB;
constexpr size_t WS_KC = 760 * MiB, WS_VC = 761 * MiB;
constexpr size_t WS_ROPE_R = 762 * MiB;
constexpr size_t WS_ROPE_N = 764 * MiB;
constexpr size_t WS_CNT = 765 * MiB;
constexpr size_t WS_BAR = 765 * MiB + 512 * 1024;
constexpr size_t WS_XBUF = 766 * MiB;
static_assert(W_END0 <= WS_XB, "weights region");
constexpr size_t R_H = 0;
constexpr size_t R_ACMP = 0;
constexpr size_t R_HC = 64 * MiB;
constexpr size_t R_QN = 0;
constexpr size_t R_O = 72 * MiB;

constexpr int LDS_BYTES = 143360;

__device__ __forceinline__ int opaque_tid() { int t = threadIdx.x; asm volatile("" : "+v"(t)); return t; }
__device__ __forceinline__ int rfl(int v) { return __builtin_amdgcn_readfirstlane(v); }
__device__ __forceinline__ unsigned f2bf(float f) { unsigned u = __builtin_bit_cast(unsigned, f); return (u + 0x7fffu + ((u >> 16) & 1u)) >> 16; }
__device__ __forceinline__ unsigned pk2(float lo, float hi) { unsigned r; asm volatile("v_cvt_pk_bf16_f32 %0, %1, %2" : "=v"(r) : "v"(lo), "v"(hi)); return r; }
__device__ __forceinline__ float bf2f(unsigned short b) { return __builtin_bit_cast(float, (unsigned)b << 16); }
__device__ __forceinline__ float bflo(unsigned w) { return __builtin_bit_cast(float, w << 16); }
__device__ __forceinline__ float bfhi(unsigned w) { return __builtin_bit_cast(float, w & 0xffff0000u); }
__device__ __forceinline__ float ex2(float x) { return __builtin_amdgcn_exp2f(x); }
__device__ __forceinline__ float siluf(float a) { return a * __builtin_amdgcn_rcpf(1.f + ex2(-1.4426950408889634f * a)); }
__device__ __forceinline__ float sigmf(float a) { return __builtin_amdgcn_rcpf(1.f + ex2(-1.4426950408889634f * a)); }
__device__ __forceinline__ float gelu_tanh(float x) {
    const float u = 0.7978845608028654f * (x + 0.044715f * x * x * x);
    const float e = ex2(2.8853900817779268f * u);
    const float th = 1.f - 2.f * __builtin_amdgcn_rcpf(e + 1.f);
    return 0.5f * x * (1.f + th);
}
__device__ __forceinline__ float wave_sum(float v) {
#pragma unroll
    for (int o = 1; o < 64; o <<= 1) v += __shfl_xor(v, o);
    return v;
}
__device__ __forceinline__ f32x4 mfma16(bf16x8 a, bf16x8 b, f32x4 c) { return __builtin_amdgcn_mfma_f32_16x16x32_bf16(a, b, c, 0, 0, 0); }
__device__ __forceinline__ f32x16 mfma32(bf16x8 a, bf16x8 b, f32x16 c) { return __builtin_amdgcn_mfma_f32_32x32x16_bf16(a, b, c, 0, 0, 0); }
typedef short v4i16_t __attribute__((ext_vector_type(4)));
__device__ __forceinline__ s16x4 trrd(ldsp p) { return __builtin_bit_cast(s16x4, __builtin_amdgcn_ds_read_tr16_b64_v4i16((LAS v4i16_t*)p)); }
__device__ __forceinline__ bf16x8 cat8(s16x4 lo, s16x4 hi) { return (bf16x8){lo[0], lo[1], lo[2], lo[3], hi[0], hi[1], hi[2], hi[3]}; }
__device__ __forceinline__ int vcu_of() { const int G = gridDim.x, bx = blockIdx.x; return (G % 8 == 0) ? (bx % 8) * (G / 8) + bx / 8 : bx; }

namespace pg8 {
constexpr int BM = 256, BK = 64, HALF = 128, HTB = HALF * BK * 2, STAGE_BYTES = 8 * HTB, NXCD = 8, WGM = 8;
__host__ __device__ __forceinline__ int lds_byte(int r, int c) { const int st = (r >> 4) * 2 + (c >> 5), rr = r & 15, cc = c & 31, ob = rr * 64 + cc * 2; return st * 1024 + (ob ^ (((ob >> 9) & 1) << 5)); }
__host__ __device__ __forceinline__ void stage_rc(int b, int& R, int& C) { const int st = b / 1024, sb = b % 1024, swz = sb ^ (((sb >> 9) & 1) << 5); R = (st >> 1) * 16 + swz / 64; C = (st & 1) * 32 + (swz % 64) / 2; }
__host__ __device__ __forceinline__ int perm32(int rho) { const int n = rho >> 4, i = rho & 15; return 8 * (i >> 2) + 4 * n + (i & 3); }
struct Unit { int pm, pn; };
struct Gemm { const bf16_t* A; const bf16_t* Bt; int M, N, K, lda; };
struct StaticOrder {
    int nM, nN, nwg, G, c;
    __device__ void init(int M_, int N_, int G_, int c_) { nM = M_ / BM; nN = N_ / BM; nwg = nM * nN; G = G_; c = c_; }
    __device__ bool next(int i, Unit& u) const {
        const long L = (long)i * G + c; if (L >= nwg) return false;
        int wgid = (int)L; { const int q = nwg / NXCD, r = nwg % NXCD, xcd = wgid % NXCD, off = wgid / NXCD; wgid = (xcd < r ? xcd * (q + 1) : r * (q + 1) + (xcd - r) * q) + off; }
        const int nig = WGM * nN, gid = wgid / nig, fm = gid * WGM, gsz = (nM - fm) < WGM ? (nM - fm) : WGM;
        u.pm = fm + ((wgid % nig) % gsz); u.pn = (wgid % nig) / gsz; return true;
    }
};
struct CmpOrder {
    int G, c;
    __device__ bool next(int i, Unit& u) const { const int L = i * G + c; if (L >= 64) return false; const int cc = L >> 5, r = L & 31; u.pm = cc * 16 + (r >> 1); u.pn = cc * 2 + (r & 1); return true; }
};

enum { EPI_SWIGLU = 0, EPI_RESID = 1, EPI_RET = 2, EPI_KV = 3, EPI_NSAQ = 4, EPI_CMP1 = 5 };
template <int MODE> struct Epi {
    static constexpr bool PERM = (MODE == EPI_SWIGLU || MODE == EPI_RET || MODE == EPI_CMP1);
    void* out; const float* src; int ldc; float alpha, beta; const float* tcos; const float* tsin;
    __device__ __forceinline__ void operator()(f32x4 (&acc)[2][2][4][2], const Unit& u, int wr, int wc, int fr, int fq) const {
        if constexpr (MODE == EPI_SWIGLU) {
            bf16_t* O = (bf16_t*)out; const int col0 = u.pn * 128 + wc * 32 + 8 * fq;
#pragma unroll
            for (int ai = 0; ai < 2; ++ai)
#pragma unroll
                for (int m = 0; m < 4; ++m) {
                    const int row = u.pm * BM + ai * HALF + wr * 64 + m * 16 + fr;
                    const f32x4 a0 = acc[ai][0][m][0], a1 = acc[ai][0][m][1], u0 = acc[ai][1][m][0], u1 = acc[ai][1][m][1];
                    u32x4 w; w.x = pk2(siluf(a0[0]) * u0[0], siluf(a0[1]) * u0[1]); w.y = pk2(siluf(a0[2]) * u0[2], siluf(a0[3]) * u0[3]);
                    w.z = pk2(siluf(a1[0]) * u1[0], siluf(a1[1]) * u1[1]); w.w = pk2(siluf(a1[2]) * u1[2], siluf(a1[3]) * u1[3]);
                    *(u32x4*)(O + (size_t)row * ldc + col0) = w;
                }
        } else if constexpr (MODE == EPI_RESID) {
            float* Y = (float*)out; const int col0 = u.pn * BM + wc * 32 + 4 * fq;
#pragma unroll
            for (int ai = 0; ai < 2; ++ai)
#pragma unroll
                for (int m = 0; m < 4; ++m) {
                    const int row = u.pm * BM + ai * HALF + wr * 64 + m * 16 + fr; const size_t off = (size_t)row * ldc + col0;
#pragma unroll
                    for (int bj = 0; bj < 2; ++bj)
#pragma unroll
                        for (int n = 0; n < 2; ++n) { const f32x4 x = *(const f32x4*)(src + off + bj * HALF + n * 16); *(f32x4*)(Y + off + bj * HALF + n * 16) = x * alpha + acc[ai][bj][m][n] * beta; }
                    asm volatile("" ::: "memory");
                }
        } else if constexpr (MODE == EPI_RET) {
            bf16_t* O = (bf16_t*)out; const int colw = wc * 32 + 8 * fq;
            if (u.pn < 16) {
                const bool isk = u.pn >= 8; const int hh = u.pn & 7; const float l2g = __builtin_log2f(1.f - ex2(-5.f - (float)hh));
#pragma unroll
                for (int ai = 0; ai < 2; ++ai)
#pragma unroll
                    for (int m = 0; m < 4; ++m) {
                        const int row = u.pm * BM + ai * HALF + wr * 64 + m * 16 + fr, pos = row & (T - 1);
                        const float sc = isk ? 0.0625f * ex2(l2g * (float)(RC - 1 - (pos & (RC - 1)))) : 1.f;
                        f32x4 o1[2], o2[2];
#pragma unroll
                        for (int n = 0; n < 2; ++n) { const f32x4 cs = *(const f32x4*)(tcos + pos * 128 + colw + 4 * n), sn = *(const f32x4*)(tsin + pos * 128 + colw + 4 * n);
                            const f32x4 x1 = acc[ai][0][m][n], x2 = acc[ai][1][m][n]; o1[n] = (x1 * cs - x2 * sn) * sc; o2[n] = (x2 * cs + x1 * sn) * sc; }
                        bf16_t* rp = O + (size_t)row * ldc + u.pn * BM + colw;
                        u32x4 w; w.x = pk2(o1[0][0], o1[0][1]); w.y = pk2(o1[0][2], o1[0][3]); w.z = pk2(o1[1][0], o1[1][1]); w.w = pk2(o1[1][2], o1[1][3]); *(u32x4*)rp = w;
                        w.x = pk2(o2[0][0], o2[0][1]); w.y = pk2(o2[0][2], o2[0][3]); w.z = pk2(o2[1][0], o2[1][1]); w.w = pk2(o2[1][2], o2[1][3]); *(u32x4*)(rp + HALF) = w;
                        asm volatile("" ::: "memory");
                    }
            } else {
#pragma unroll
                for (int ai = 0; ai < 2; ++ai)
#pragma unroll
                    for (int m = 0; m < 4; ++m) {
                        const int row = u.pm * BM + ai * HALF + wr * 64 + m * 16 + fr; bf16_t* rp = O + (size_t)row * ldc + u.pn * BM + colw;
#pragma unroll
                        for (int bj = 0; bj < 2; ++bj) { const f32x4 v0 = acc[ai][bj][m][0], v1 = acc[ai][bj][m][1]; u32x4 w; w.x = pk2(v0[0], v0[1]); w.y = pk2(v0[2], v0[3]); w.z = pk2(v1[0], v1[1]); w.w = pk2(v1[2], v1[3]); *(u32x4*)(rp + bj * HALF) = w; }
                    }
            }
        } else if constexpr (MODE == EPI_KV || MODE == EPI_NSAQ) {
            bf16_t* O = (bf16_t*)out;
            bool rope; float sc = 1.f;
            if constexpr (MODE == EPI_KV) { const int cidx = u.pn >> 1; rope = (cidx == 2 || cidx == 4) && wc == 0; }
            else { rope = (u.pn < 8) && wc == 0; sc = (u.pn < 8) ? alpha : 1.f; }
#pragma unroll
            for (int ai = 0; ai < 2; ++ai)
#pragma unroll
                for (int m = 0; m < 4; ++m) {
                    const int row = u.pm * BM + ai * HALF + wr * 64 + m * 16 + fr, pos = row & (T - 1);
                    f32x4 cs = (f32x4){1.f, 1.f, 1.f, 1.f}, sn = (f32x4){0.f, 0.f, 0.f, 0.f};
                    if (rope) { cs = *(const f32x4*)(tcos + pos * 16 + 4 * fq); sn = *(const f32x4*)(tsin + pos * 16 + 4 * fq); }
                    bf16_t* rp = O + (size_t)row * ldc + u.pn * BM + wc * 32 + 4 * fq;
#pragma unroll
                    for (int bj = 0; bj < 2; ++bj) { const f32x4 x1 = acc[ai][bj][m][0], x2 = acc[ai][bj][m][1];
                        const f32x4 o1 = (x1 * cs - x2 * sn) * sc, o2 = (x2 * cs + x1 * sn) * sc;
                        u32x2 w; w.x = pk2(o1[0], o1[1]); w.y = pk2(o1[2], o1[3]); *(u32x2*)(rp + bj * HALF) = w;
                        w.x = pk2(o2[0], o2[1]); w.y = pk2(o2[2], o2[3]); *(u32x2*)(rp + bj * HALF + 16) = w; }
                    asm volatile("" ::: "memory");
                }
        } else {
            bf16_t* O = (bf16_t*)out; const int colw = wc * 32 + 8 * fq;
#pragma unroll
            for (int ai = 0; ai < 2; ++ai)
#pragma unroll
                for (int m = 0; m < 4; ++m) {
                    const int row = u.pm * BM + ai * HALF + wr * 64 + m * 16 + fr; bf16_t* rp = O + (size_t)row * ldc + (u.pn & 1) * BM + colw;
#pragma unroll
                    for (int bj = 0; bj < 2; ++bj) { const float* bp = src + u.pn * BM + bj * HALF + colw; const f32x4 b0 = *(const f32x4*)bp, b1 = *(const f32x4*)(bp + 4);
                        const f32x4 v0 = acc[ai][bj][m][0] + b0, v1 = acc[ai][bj][m][1] + b1; u32x4 w;
                        w.x = pk2(gelu_tanh(v0[0]), gelu_tanh(v0[1])); w.y = pk2(gelu_tanh(v0[2]), gelu_tanh(v0[3])); w.z = pk2(gelu_tanh(v1[0]), gelu_tanh(v1[1])); w.w = pk2(gelu_tanh(v1[2]), gelu_tanh(v1[3]));
                        *(u32x4*)(rp + bj * HALF) = w; }
                    asm volatile("" ::: "memory");
                }
        }
    }
};

struct LnOrder {
    int vcu;
    __device__ bool next(int i, Unit& u) const { if (i >= 2) return false; u.pm = 32 * i + (vcu >> 3); u.pn = vcu & 7; return true; }
};
struct EpiLN {
    static constexpr bool PERM = false;
    float* dst; const float* src; bf16_t* xb; const float* g; const float* b; float alpha, beta;
    unsigned long long* xbuf; unsigned* cnt; ldsp xl; int live;
    __device__ __forceinline__ void operator()(f32x4 (&acc)[2][2][4][2], const Unit& u, int wr, int wc, int fr_in, int fq_in) const {
        typedef float f32x2v __attribute__((ext_vector_type(2)));
        int tid = threadIdx.x; asm volatile("" : "+v"(tid));
        const int wid = rfl(tid >> 6), lane = tid & 63, fr = lane & 15, fq = lane >> 4; (void)fr_in; (void)fq_in;
        LAS f32x2v* P = (LAS f32x2v*)xl; LAS f32x2v* S = (LAS f32x2v*)(xl + 8192);
        const int col0 = u.pn * BM + wc * 32 + 4 * fq;
#pragma unroll
        for (int ai = 0; ai < 2; ++ai)
#pragma unroll
            for (int m = 0; m < 4; ++m) { const size_t off = (size_t)(u.pm * BM + ai * HALF + wr * 64 + m * 16 + fr) * D + col0;
#pragma unroll
                for (int bj = 0; bj < 2; ++bj)
#pragma unroll
                    for (int n = 0; n < 2; ++n) { const f32x4 x = *(const f32x4*)(src + off + bj * HALF + n * 16); acc[ai][bj][m][n] = x * alpha + acc[ai][bj][m][n] * beta; }
                asm volatile("" : "+v"(acc[ai][0][m][0]), "+v"(acc[ai][0][m][1]), "+v"(acc[ai][1][m][0]), "+v"(acc[ai][1][m][1]));
                asm volatile("" ::: "memory"); }
#pragma unroll
        for (int ai = 0; ai < 2; ++ai)
#pragma unroll
            for (int m = 0; m < 4; ++m) {
                float sm = 0.f;
#pragma unroll
                for (int bj = 0; bj < 2; ++bj)
#pragma unroll
                    for (int n = 0; n < 2; ++n) { const f32x4 x = acc[ai][bj][m][n]; sm += (x[0] + x[1]) + (x[2] + x[3]); }
                sm += __shfl_xor(sm, 16); sm += __shfl_xor(sm, 32);
                const float mw = sm * (1.0f / 64.0f); float q = 0.f;
#pragma unroll
                for (int bj = 0; bj < 2; ++bj)
#pragma unroll
                    for (int n = 0; n < 2; ++n) { const f32x4 d = acc[ai][bj][m][n] - mw; q += (d[0] * d[0] + d[1] * d[1]) + (d[2] * d[2] + d[3] * d[3]); }
                q += __shfl_xor(q, 16); q += __shfl_xor(q, 32);
                if (fq == 0) P[(ai * HALF + wr * 64 + m * 16 + fr) * 4 + wc] = (f32x2v){mw, q};
            }
        asm volatile("s_waitcnt lgkmcnt(0)" ::: "memory"); __builtin_amdgcn_s_barrier(); asm volatile("" ::: "memory");
        const int row = wid * 32 + (lane & 31);
        if (lane < 32) {
            const f32x2v a = P[row * 4 + 0], bq = P[row * 4 + 1], c = P[row * 4 + 2], d = P[row * 4 + 3];
            const float mt = (a.x + bq.x + c.x + d.x) * 0.25f;
            const float da = a.x - mt, db = bq.x - mt, dc = c.x - mt, dd = d.x - mt;
            const float m2 = (a.y + bq.y) + (c.y + d.y) + 64.0f * ((da * da + db * db) + (dc * dc + dd * dd));
            unsigned long long* slot = xbuf + ((size_t)(u.pm * BM + row) * 8 + u.pn);
            __hip_atomic_store(slot, ((unsigned long long)__float_as_uint(m2) << 32) | __float_as_uint(mt), __ATOMIC_RELAXED, __HIP_MEMORY_SCOPE_AGENT);
        }
        asm volatile("s_waitcnt vmcnt(0)" ::: "memory");
        if (lane == 0) __hip_atomic_fetch_add(cnt + 64 * u.pm, 1u, __ATOMIC_RELAXED, __HIP_MEMORY_SCOPE_AGENT);
        if (wid == 0) {
            unsigned spins = 0;
            while (live) {
                if ((unsigned)__builtin_amdgcn_readfirstlane(__hip_atomic_load(cnt + 64 * u.pm, __ATOMIC_RELAXED, __HIP_MEMORY_SCOPE_AGENT)) >= 64u) break;
                if (++spins > (1u << 22)) break;
                __builtin_amdgcn_s_sleep(2);
            }
            __builtin_amdgcn_fence(__ATOMIC_ACQUIRE, "agent");
        }
        asm volatile("s_waitcnt vmcnt(0) lgkmcnt(0)" ::: "memory"); __builtin_amdgcn_s_barrier(); asm volatile("" ::: "memory");
        if (lane < 32) {
            const unsigned long long* slot = xbuf + (size_t)(u.pm * BM + row) * 8; float mt[8], m2[8]; float ms = 0.f;
#pragma unroll
            for (int t = 0; t < 8; ++t) { const unsigned long long w = __hip_atomic_load(slot + t, __ATOMIC_RELAXED, __HIP_MEMORY_SCOPE_AGENT); mt[t] = __uint_as_float((unsigned)w); m2[t] = __uint_as_float((unsigned)(w >> 32)); ms += mt[t]; }
            const float mean = ms * 0.125f; float q = 0.f;
#pragma unroll
            for (int t = 0; t < 8; ++t) { const float dm = mt[t] - mean; q += m2[t] + 256.0f * dm * dm; }
            S[row] = (f32x2v){mean, 1.0f / sqrtf(q * (1.0f / 2048.0f) + LN_EPS)};
        }
        asm volatile("s_waitcnt lgkmcnt(0)" ::: "memory"); __builtin_amdgcn_s_barrier(); asm volatile("" ::: "memory");
        int col5 = col0; asm volatile("" : "+v"(col5));
#pragma unroll
        for (int bj = 0; bj < 2; ++bj)
#pragma unroll
            for (int n = 0; n < 2; ++n) { const f32x4 gv = *(const f32x4*)(g + col5 + bj * HALF + n * 16), bv = *(const f32x4*)(b + col5 + bj * HALF + n * 16);
#pragma unroll
                for (int ai = 0; ai < 2; ++ai)
#pragma unroll
                    for (int m = 0; m < 4; ++m) { const int r = ai * HALF + wr * 64 + m * 16 + fr; const f32x2v sr = S[r]; const size_t off = (size_t)(u.pm * BM + r) * D + col5 + bj * HALF + n * 16;
                        const f32x4 o = (acc[ai][bj][m][n] - sr.x) * sr.y * gv + bv; *(f32x4*)(dst + off) = o;
                        u32x2 w; w.x = pk2(o[0], o[1]); w.y = pk2(o[2], o[3]); *(u32x2*)(xb + off) = w; }
                asm volatile("" ::: "memory"); }
        asm volatile("s_waitcnt lgkmcnt(0)" ::: "memory"); __builtin_amdgcn_s_barrier(); asm volatile("" ::: "memory");
    }
};

template <class Epi, class Sched>
__device__ __forceinline__ void gemm_phase(ldsp lds, const Gemm g, const Sched& S, const Epi& E) {
    const int tid = opaque_tid(), wid = __builtin_amdgcn_readfirstlane(tid >> 6), lane = tid & 63, wr = wid >> 2, wc = wid & 3, fr = lane & 15, fq = lane >> 4;
    const int K = g.K, nt = K / BK, lda = g.lda;
    unsigned voffA[2], voffB[2];
#pragma unroll
    for (int i = 0; i < 2; ++i) { int R, C; stage_rc(tid * 16 + i * 8192, R, C); const int Rb = Epi::PERM ? ((R & ~31) + perm32(R & 31)) : R;
        voffA[i] = (unsigned)(R * lda + C) * 2u; voffB[i] = (unsigned)(Rb * K + C) * 2u; }
    const size_t kstep = (size_t)(BK * 2);
    const size_t hstepA = (size_t)HALF * lda * 2, hstepB = (size_t)HALF * K * 2;
    const size_t tstepA = 2 * hstepA, tstepB = 2 * hstepB;
    const unsigned ldsw = (unsigned)wid * 1024u;
    const int aoff = lds_byte(wr * 64 + fr, fq * 8), boff = lds_byte(wc * 32 + fr, fq * 8);
#define PG8_SA(b, h) (((b) * 2 + (h)) * HTB)
#define PG8_SB(b, h) ((4 + (b) * 2 + (h)) * HTB)
#define PG8_STAGE(bufoff, gbase, voff) do { _Pragma("unroll") for (int _i = 0; _i < 2; ++_i) \
        __builtin_amdgcn_global_load_lds((const unsigned*)((const char*)(gbase) + (voff)[_i]), (LAS unsigned*)(lds + (bufoff) + ldsw + _i * 8192), 16, 0, 0); } while (0)
#define PG8_LDA(dst, b, h) do { _Pragma("unroll") for (int m = 0; m < 4; ++m) _Pragma("unroll") for (int k = 0; k < 2; ++k) dst[m][k] = *(const LAS bf16x8*)(lds + PG8_SA(b, h) + aoff + m * 2048 + k * 1024); } while (0)
#define PG8_LDB(dst, b, h) do { _Pragma("unroll") for (int n = 0; n < 2; ++n) _Pragma("unroll") for (int k = 0; k < 2; ++k) dst[n][k] = *(const LAS bf16x8*)(lds + PG8_SB(b, h) + boff + n * 2048 + k * 1024); } while (0)
#define PG8_MMA(ai, bj, At, Bt) do { __builtin_amdgcn_s_setprio(1); _Pragma("unroll") for (int m = 0; m < 4; ++m) _Pragma("unroll") for (int n = 0; n < 2; ++n) _Pragma("unroll") for (int k = 0; k < 2; ++k) \
        acc[ai][bj][m][n] = __builtin_amdgcn_mfma_f32_16x16x32_bf16(Bt[n][k], At[m][k], acc[ai][bj][m][n], 0, 0, 0); __builtin_amdgcn_s_setprio(0); } while (0)
#define PG8_WAIT_V(n) asm volatile("s_waitcnt vmcnt(" #n ")" ::: "memory")
#define PG8_WAIT_L(n) asm volatile("s_waitcnt lgkmcnt(" #n ")" ::: "memory")
#define PG8_BAR __builtin_amdgcn_s_barrier()
#define PG8_SCHED __builtin_amdgcn_sched_barrier(0)
    Unit cur, nxt; int ui = 0;
    if (!S.next(0, cur)) return;
    f32x4 acc[2][2][4][2];
#pragma unroll
    for (int a = 0; a < 2; ++a)
#pragma unroll
        for (int b = 0; b < 2; ++b)
#pragma unroll
            for (int m = 0; m < 4; ++m)
#pragma unroll
                for (int n = 0; n < 2; ++n) acc[a][b][m][n] = (f32x4){0.f, 0.f, 0.f, 0.f};
    bf16x8 At[4][2], B0[2][2], B1[2][2];
    const char* cA = (const char*)g.A + (size_t)cur.pm * tstepA; const char* cB = (const char*)g.Bt + (size_t)cur.pn * tstepB;
    PG8_STAGE(PG8_SB(0, 0), cB, voffB); PG8_STAGE(PG8_SB(0, 1), cB + hstepB, voffB); PG8_STAGE(PG8_SA(0, 0), cA, voffA); PG8_STAGE(PG8_SA(0, 1), cA + hstepA, voffA);
    if (wr == 1) PG8_BAR;
    PG8_WAIT_V(2); PG8_BAR;
    PG8_STAGE(PG8_SB(1, 0), cB + kstep, voffB); PG8_STAGE(PG8_SA(1, 0), cA + kstep, voffA); PG8_STAGE(PG8_SB(1, 1), cB + hstepB + kstep, voffB);
    PG8_WAIT_V(6); PG8_BAR;
    for (;;) {
        const bool has_next = S.next(ui + 1, nxt);
        const char* nA = has_next ? (const char*)g.A + (size_t)nxt.pm * tstepA : cA; const char* nB = has_next ? (const char*)g.Bt + (size_t)nxt.pn * tstepB : cB;
        for (int t = 0; t < nt; t += 2) {
            const bool last = (t == nt - 2);
            const char* a1 = cA + (size_t)(t + 1) * kstep;
            const char* a2 = last ? nA : cA + (size_t)(t + 2) * kstep; const char* b2 = last ? nB : cB + (size_t)(t + 2) * kstep;
            const char* a3 = a2 + kstep; const char* b3 = b2 + kstep;
            PG8_LDB(B0, 0, 0); PG8_LDB(B1, 0, 1); PG8_SCHED; PG8_LDA(At, 0, 0); PG8_STAGE(PG8_SA(1, 1), a1 + hstepA, voffA);
            PG8_WAIT_V(8); PG8_WAIT_L(0); PG8_BAR; PG8_MMA(0, 0, At, B0); PG8_MMA(0, 1, At, B1); PG8_BAR; PG8_SCHED;
            PG8_LDA(At, 0, 1); PG8_STAGE(PG8_SB(0, 0), b2, voffB); PG8_STAGE(PG8_SB(0, 1), b2 + hstepB, voffB); PG8_STAGE(PG8_SA(0, 0), a2, voffA);
            PG8_WAIT_V(8); PG8_WAIT_L(0); PG8_BAR; PG8_MMA(1, 0, At, B0); PG8_MMA(1, 1, At, B1); PG8_BAR; PG8_SCHED;
            PG8_LDB(B0, 1, 0); PG8_LDB(B1, 1, 1); PG8_SCHED; PG8_LDA(At, 1, 0); PG8_STAGE(PG8_SA(0, 1), a2 + hstepA, voffA);
            PG8_WAIT_V(8); PG8_WAIT_L(0); PG8_BAR; PG8_MMA(0, 0, At, B0); PG8_MMA(0, 1, At, B1); PG8_BAR; PG8_SCHED;
            PG8_LDA(At, 1, 1); PG8_STAGE(PG8_SB(1, 0), b3, voffB); PG8_STAGE(PG8_SB(1, 1), b3 + hstepB, voffB); PG8_STAGE(PG8_SA(1, 0), a3, voffA);
            PG8_WAIT_V(8); PG8_WAIT_L(0); PG8_BAR; PG8_MMA(1, 0, At, B0); PG8_MMA(1, 1, At, B1); PG8_BAR; PG8_SCHED;
        }
        if (wr == 0) PG8_BAR;
        E(acc, cur, wr, wc, fr, fq);
        if (!has_next) break;
#pragma unroll
        for (int a = 0; a < 2; ++a)
#pragma unroll
            for (int b = 0; b < 2; ++b)
#pragma unroll
                for (int m = 0; m < 4; ++m)
#pragma unroll
                    for (int n = 0; n < 2; ++n) acc[a][b][m][n] = (f32x4){0.f, 0.f, 0.f, 0.f};
        cur = nxt; cA = nA; cB = nB; ++ui;
        if (wr == 1) PG8_BAR;
    }
    PG8_WAIT_V(0);
    PG8_BAR;
#undef PG8_SA
#undef PG8_SB
#undef PG8_STAGE
#undef PG8_LDA
#undef PG8_LDB
#undef PG8_MMA
#undef PG8_WAIT_V
#undef PG8_WAIT_L
#undef PG8_BAR
#undef PG8_SCHED
}
}

struct Params {
    const float* x; const float* ln_g; const float* ln_b;
    const float* ffn1_in; const float* ffn1_out; const float* ffn2_in; const float* ffn2_out;
    const float* ret_in; const float* gn_g; const float* gn_b; const float* ret_out;
    const float* kv_w; const float* cmp_pos; const float* cmp_w1; const float* cmp_b1; const float* cmp_w2;
    const float* nsa_q; const float* nsa_out;
    float* out; unsigned char* ws;
    int ph_lo, ph_hi;
};

__device__ __forceinline__ int dest_row(int n, int mode) { if (mode == 0) return n; const int isu = n >= FF ? 1 : 0, j = n - isu * FF; return (j >> 7) * 256 + isu * 128 + (j & 127); }
__device__ __forceinline__ void transpose_item(const float* W, int K, int N, bf16_t* WT, int mode, LAS float* scr, int item, int nblk, int lane) {
    const int kb = item / nblk, nb = item % nblk, k0 = 64 * kb, n0 = 64 * nb;
    const int nq = 4 * (lane & 15), kr = lane >> 4;
    const bool inb = (n0 + nq) < N;
    f32x4 v[16];
#pragma unroll
    for (int i = 0; i < 16; ++i) v[i] = inb ? *(const f32x4*)(W + (size_t)(k0 + 4 * i + kr) * N + n0 + nq) : (f32x4){0.f, 0.f, 0.f, 0.f};
#pragma unroll
    for (int i = 0; i < 16; ++i) { LAS float* d = scr + (4 * i + kr) * 65 + nq; d[0] = v[i][0]; d[1] = v[i][1]; d[2] = v[i][2]; d[3] = v[i][3]; }
    asm volatile("s_waitcnt lgkmcnt(0)" ::: "memory");
    const int c = lane & 7;
#pragma unroll
    for (int j = 0; j < 8; ++j) { const int n = (lane >> 3) + 8 * j; const LAS float* sp = scr + (8 * c) * 65 + n;
        u32x4 o; o.x = pk2(sp[0 * 65], sp[1 * 65]); o.y = pk2(sp[2 * 65], sp[3 * 65]); o.z = pk2(sp[4 * 65], sp[5 * 65]); o.w = pk2(sp[6 * 65], sp[7 * 65]);
        *(u32x4*)(WT + (size_t)dest_row(n0 + n, mode) * K + k0 + 8 * c) = o; }
    asm volatile("s_waitcnt lgkmcnt(0)" ::: "memory");
}
__device__ __forceinline__ void convert_part(ldsp lds, const float* W, int K, int N, int Npad, int mode, bf16_t* WT, int gw, int NGW) {
    const int tid = opaque_tid(), lane = tid & 63, wave = rfl(tid >> 6);
    LAS float* scr = (LAS float*)(lds + wave * 16640);
    const int nblk = Npad / 64, nitems = (K / 64) * nblk;
    for (int it = gw; it < nitems; it += NGW) transpose_item(W, K, N, WT, mode, scr, it, nblk, lane);
}
__device__ __forceinline__ void convert_one(ldsp lds, const float* W, int K, int N, int Npad, int mode, bf16_t* WT) {
    const int wave = rfl((int)threadIdx.x >> 6);
    convert_part(lds, W, K, N, Npad, mode, WT, blockIdx.x * 8 + wave, gridDim.x * 8);
}

__device__ __forceinline__ void ln_phase(const float* Y, float* X, bf16_t* Xb, const float* g, const float* b) {
    const int tid = opaque_tid(), lane = tid & 63, wave = rfl(tid >> 6);
    const int gw = blockIdx.x * 8 + wave, NGW = gridDim.x * 8;
    f32x4 gv[8], bv[8];
#pragma unroll
    for (int j = 0; j < 8; ++j) { gv[j] = *(const f32x4*)(g + 4 * lane + 256 * j); bv[j] = *(const f32x4*)(b + 4 * lane + 256 * j); }
    for (int m = gw; m < M; m += NGW) {
        const f32x4* yr = (const f32x4*)(Y + (size_t)m * D) + lane; f32x4 v[8]; float s = 0.f;
#pragma unroll
        for (int j = 0; j < 8; ++j) { v[j] = yr[64 * j]; s += (v[j][0] + v[j][1]) + (v[j][2] + v[j][3]); }
        const float mean = wave_sum(s) * (1.f / D); float s2 = 0.f;
#pragma unroll
        for (int j = 0; j < 8; ++j) { v[j] = v[j] - mean; s2 += (v[j][0] * v[j][0] + v[j][1] * v[j][1]) + (v[j][2] * v[j][2] + v[j][3] * v[j][3]); }
        const float rstd = 1.f / sqrtf(wave_sum(s2) * (1.f / D) + LN_EPS);
        f32x4* xr = (f32x4*)(X + (size_t)m * D) + lane; u32x2* br = (u32x2*)(Xb + (size_t)m * D) + lane;
#pragma unroll
        for (int j = 0; j < 8; ++j) { const f32x4 o = v[j] * rstd * gv[j] + bv[j]; xr[64 * j] = o; u32x2 w; w.x = pk2(o[0], o[1]); w.y = pk2(o[2], o[3]); br[64 * j] = w; }
    }
}

__device__ __forceinline__ void ret_phase(ldsp lds, bf16_t* R) {
    const int tid = opaque_tid(), lane = tid & 63, w = rfl(tid >> 6);
    constexpr int QS = 528, VS = 272, SS = 144;
    ldsp Qs = lds, Ks = lds + 64 * QS, Vs = lds + 128 * QS, Ss = lds + 128 * QS + 64 * VS;
    const int G = gridDim.x, vcu = vcu_of();
    for (int u = vcu; u < 256; u += G) {
        const int b = u >> 5, h = (u >> 2) & 7, vs = u & 3;
        const float l2g = __builtin_log2f(1.f - ex2(-5.f - (float)h));
        const float gC = ex2(l2g * (float)RC);
        f32x4 St[16];
#pragma unroll
        for (int k = 0; k < 16; ++k) St[k] = (f32x4){0.f, 0.f, 0.f, 0.f};
        bf16_t* Rb = R + (size_t)b * T * RETC;
        const int qc = h * 256, kc = 2048 + h * 256, vc = 4096 + h * 512 + vs * 128, vbase = 16 * w;
        u32x4 pq[4], pk[4], pv[2];
#define RET_GLOAD(cc) do { const bf16_t* Rn_ = Rb + (size_t)(RC * (cc)) * RETC; \
            _Pragma("unroll") for (int i = 0; i < 4; ++i) { const int p = tid + 512 * i, r = p >> 5, ch = p & 31; pq[i] = *(const u32x4*)(Rn_ + (size_t)r * RETC + qc + ch * 8); pk[i] = *(const u32x4*)(Rn_ + (size_t)r * RETC + kc + ch * 8); } \
            _Pragma("unroll") for (int i = 0; i < 2; ++i) { const int p = tid + 512 * i, r = p >> 4, ch = p & 15; pv[i] = *(const u32x4*)(Rn_ + (size_t)r * RETC + vc + ch * 8); } } while (0)
        RET_GLOAD(0);
        for (int c = 0; c < T / RC; ++c) {
            bf16_t* Rc = Rb + (size_t)(RC * c) * RETC;
            __syncthreads();
#pragma unroll
            for (int i = 0; i < 4; ++i) { const int p = tid + 512 * i, r = p >> 5, ch = p & 31; *(LAS u32x4*)(Qs + r * QS + ch * 16) = pq[i]; *(LAS u32x4*)(Ks + r * QS + ch * 16) = pk[i]; }
#pragma unroll
            for (int i = 0; i < 2; ++i) { const int p = tid + 512 * i, r = p >> 4, ch = p & 15; *(LAS u32x4*)(Vs + r * VS + ch * 16) = pv[i]; }
            __syncthreads();
            if (c + 1 < T / RC) RET_GLOAD(c + 1);
            int lane_o = lane; asm volatile("" : "+v"(lane_o));
            const int li = lane_o & 15, g4 = lane_o >> 4, tq = li >> 2, tp = li & 3;
            {
                const int nt = w >> 1;
#pragma unroll
                for (int mt2 = 0; mt2 < 2; ++mt2) { const int mt = 2 * (w & 1) + mt2; f32x4 acc = (f32x4){0.f, 0.f, 0.f, 0.f};
                    if (mt <= nt) {
#pragma unroll
                        for (int ks = 0; ks < 8; ++ks) { const bf16x8 a = *(const LAS bf16x8*)(Qs + (16 * nt + li) * QS + (32 * ks + 8 * g4) * 2), bb = *(const LAS bf16x8*)(Ks + (16 * mt + li) * QS + (32 * ks + 8 * g4) * 2); acc = mfma16(a, bb, acc); }
                    }
#pragma unroll
                    for (int i = 0; i < 4; ++i) { const int n = 16 * nt + 4 * g4 + i, mm = 16 * mt + li; const float val = (mm <= n) ? acc[i] * ex2(l2g * (float)(n - (RC - 1))) : 0.f; *(LAS bf16_t*)(Ss + n * SS + mm * 2) = (bf16_t)f2bf(val); }
                }
            }
            __syncthreads();
            bf16x8 vf[2];
#pragma unroll
            for (int ms = 0; ms < 2; ++ms) { const s16x4 lo = trrd(Vs + (32 * ms + 8 * g4 + tq) * VS + (vbase + 4 * tp) * 2), hi = trrd(Vs + (32 * ms + 8 * g4 + 4 + tq) * VS + (vbase + 4 * tp) * 2); vf[ms] = cat8(lo, hi); }
            bf16x8 sb[8];
#pragma unroll
            for (int ks = 0; ks < 8; ++ks) { u32x4 wv; wv.x = pk2(St[2 * ks][0], St[2 * ks][1]); wv.y = pk2(St[2 * ks][2], St[2 * ks][3]); wv.z = pk2(St[2 * ks + 1][0], St[2 * ks + 1][1]); wv.w = pk2(St[2 * ks + 1][2], St[2 * ks + 1][3]); sb[ks] = __builtin_bit_cast(bf16x8, wv); }
#pragma unroll
            for (int nt = 0; nt < 4; ++nt) {
                f32x4 o = (f32x4){0.f, 0.f, 0.f, 0.f}, cr = (f32x4){0.f, 0.f, 0.f, 0.f};
#pragma unroll
                for (int ms = 0; ms < 2; ++ms) if (32 * ms <= 16 * nt + 15) { const bf16x8 a = *(const LAS bf16x8*)(Ss + (16 * nt + li) * SS + (32 * ms + 8 * g4) * 2); o = mfma16(a, vf[ms], o); }
#pragma unroll
                for (int ks = 0; ks < 8; ++ks) { const s16x4 lo = *(const LAS s16x4*)(Qs + (16 * nt + li) * QS + (32 * ks + 4 * g4) * 2), hi = *(const LAS s16x4*)(Qs + (16 * nt + li) * QS + (32 * ks + 16 + 4 * g4) * 2); cr = mfma16(cat8(lo, hi), sb[ks], cr); }
#pragma unroll
                for (int i = 0; i < 4; ++i) { const int n = 16 * nt + 4 * g4 + i; const float val = o[i] + ex2(l2g * (float)(n + 1)) * cr[i]; Rc[(size_t)n * RETC + vc + vbase + li] = (bf16_t)f2bf(val); }
                __builtin_amdgcn_sched_barrier(0);
            }
#pragma unroll
            for (int kt = 0; kt < 16; ++kt) { St[kt] = St[kt] * gC;
#pragma unroll
                for (int ms = 0; ms < 2; ++ms) { const s16x4 lo = trrd(Ks + (32 * ms + 8 * g4 + tq) * QS + (16 * kt + 4 * tp) * 2), hi = trrd(Ks + (32 * ms + 8 * g4 + 4 + tq) * QS + (16 * kt + 4 * tp) * 2); St[kt] = mfma16(cat8(lo, hi), vf[ms], St[kt]); }
                if (kt & 1) __builtin_amdgcn_sched_barrier(0);
            }
        }
    }
#undef RET_GLOAD
    __syncthreads();
}

__device__ __forceinline__ void gn_phase(bf16_t* R, const float* gg, const float* gb) {
    const int tid = opaque_tid(), lane = tid & 63, wave = rfl(tid >> 6);
    const int gw = blockIdx.x * 8 + wave, NGW = gridDim.x * 8;
    for (int it = gw; it < M * 8; it += NGW) {
        const int row = it >> 3, h = it & 7;
        bf16_t* op = R + (size_t)row * RETC + 4096 + h * 512 + 8 * lane; bf16_t* gp = op + 4096;
        const u32x4 ov = *(const u32x4*)op, gv = *(const u32x4*)gp;
        float o[8] = {bflo(ov.x), bfhi(ov.x), bflo(ov.y), bfhi(ov.y), bflo(ov.z), bfhi(ov.z), bflo(ov.w), bfhi(ov.w)};
        float gt[8] = {bflo(gv.x), bfhi(gv.x), bflo(gv.y), bfhi(gv.y), bflo(gv.z), bfhi(gv.z), bflo(gv.w), bfhi(gv.w)};
        float s = 0.f;
#pragma unroll
        for (int i = 0; i < 8; ++i) s += o[i];
        const float mean = wave_sum(s) * (1.f / 512.f); float s2 = 0.f;
#pragma unroll
        for (int i = 0; i < 8; ++i) { o[i] -= mean; s2 += o[i] * o[i]; }
        const float rstd = 1.f / sqrtf(wave_sum(s2) * (1.f / 512.f) + LN_EPS);
        const f32x4 g0 = *(const f32x4*)(gg + h * 512 + 8 * lane), g1 = *(const f32x4*)(gg + h * 512 + 8 * lane + 4), b0 = *(const f32x4*)(gb + h * 512 + 8 * lane), b1 = *(const f32x4*)(gb + h * 512 + 8 * lane + 4);
        float y[8];
#pragma unroll
        for (int i = 0; i < 8; ++i) { const float gi = i < 4 ? g0[i & 3] : g1[i & 3], bi = i < 4 ? b0[i & 3] : b1[i & 3]; y[i] = siluf(gt[i]) * (o[i] * rstd * gi + bi); }
        u32x4 w; w.x = pk2(y[0], y[1]); w.y = pk2(y[2], y[3]); w.z = pk2(y[4], y[5]); w.w = pk2(y[6], y[7]); *(u32x4*)gp = w;
    }
}

__device__ __forceinline__ void cmp_gather_phase(const bf16_t* KV, const float* cmp_pos, bf16_t* A) {
    const size_t gt = (size_t)blockIdx.x * 512 + threadIdx.x, NT = (size_t)gridDim.x * 512;
    for (size_t p = gt; p < (size_t)2 * 4096 * 512; p += NT) {
        const int dch = (int)(p & 15), l = (int)((p >> 4) & 31), Rr = (int)((p >> 9) & 4095), c = (int)(p >> 21);
        const int n = Rr & 127, bg = Rr >> 7, b = bg >> 2, g = bg & 3;
        u32x4 w = (u32x4){0u, 0u, 0u, 0u};
        if (n < 127) {
            const u32x4 kv = *(const u32x4*)(KV + (size_t)(b * T + 16 * n + l) * KVC + c * 512 + g * 128 + dch * 8);
            const float* pp = cmp_pos + (c * 32 + l) * 128 + dch * 8; const f32x4 p0 = *(const f32x4*)pp, p1 = *(const f32x4*)(pp + 4);
            w.x = pk2(bflo(kv.x) + p0[0], bfhi(kv.x) + p0[1]); w.y = pk2(bflo(kv.y) + p0[2], bfhi(kv.y) + p0[3]); w.z = pk2(bflo(kv.z) + p1[0], bfhi(kv.z) + p1[1]); w.w = pk2(bflo(kv.w) + p1[2], bfhi(kv.w) + p1[3]);
        }
        *(u32x4*)(A + ((size_t)c * 4096 + Rr) * 4096 + l * 128 + dch * 8) = w;
    }
}
__device__ __forceinline__ void cmp2_phase(const bf16_t* Hc, const float* W2, const float* ncos, const float* nsin, bf16_t* Kc, bf16_t* Vc) {
    const int gt = blockIdx.x * 512 + threadIdx.x, NT = gridDim.x * 512;
    for (int p = gt; p < 2 * 4096 * 16; p += NT) {
        const int dq = p & 15, Rr = (p >> 4) & 4095, c = p >> 16;
        const bf16_t* hr = Hc + ((size_t)c * 4096 + Rr) * 512; const float* w2 = W2 + (size_t)c * 512 * 128 + dq;
        float acc[8];
#pragma unroll
        for (int i = 0; i < 8; ++i) acc[i] = 0.f;
        for (int e0 = 0; e0 < 512; e0 += 8) {
            const u32x4 hv = *(const u32x4*)(hr + e0);
            const float hh[8] = {bflo(hv.x), bfhi(hv.x), bflo(hv.y), bfhi(hv.y), bflo(hv.z), bfhi(hv.z), bflo(hv.w), bfhi(hv.w)};
#pragma unroll
            for (int e = 0; e < 8; ++e)
#pragma unroll
                for (int i = 0; i < 8; ++i) acc[i] += hh[e] * w2[(size_t)(e0 + e) * 128 + 16 * i];
        }
        const int n = Rr & 127;
        if (c == 0) { const int pos = (16 * n + 31) & (T - 1); const float cs = ncos[pos * 16 + dq], sn = nsin[pos * 16 + dq]; const float x1 = acc[0], x2 = acc[1]; acc[0] = x1 * cs - x2 * sn; acc[1] = x2 * cs + x1 * sn; }
        bf16_t* o = (c == 0 ? Kc : Vc) + (size_t)Rr * 128 + dq;
#pragma unroll
        for (int i = 0; i < 8; ++i) o[16 * i] = (bf16_t)f2bf(acc[i]);
    }
}

constexpr int KSTR = 272;
__device__ __forceinline__ void load_tile64(ldsp dst, const bf16_t* src, int ld, int tid) {
#pragma unroll
    for (int i = 0; i < 2; ++i) { const int p = tid + 512 * i, r = p >> 4, ch = p & 15; const u32x4 v = *(const u32x4*)(src + (size_t)r * ld + ch * 8); *(LAS u32x4*)(dst + r * KSTR + ch * 16) = v; }
}
struct TileRegs { u32x4 k0, k1, v0, v1; };
__device__ __forceinline__ void tile_gload(TileRegs& r, const bf16_t* kp, const bf16_t* vp, int ld, int tid) {
    const int p0 = tid, p1 = tid + 512;
    r.k0 = *(const u32x4*)(kp + (size_t)(p0 >> 4) * ld + (p0 & 15) * 8); r.k1 = *(const u32x4*)(kp + (size_t)(p1 >> 4) * ld + (p1 & 15) * 8);
    r.v0 = *(const u32x4*)(vp + (size_t)(p0 >> 4) * ld + (p0 & 15) * 8); r.v1 = *(const u32x4*)(vp + (size_t)(p1 >> 4) * ld + (p1 & 15) * 8);
}
__device__ __forceinline__ void tile_lstore(ldsp Kt, ldsp Vt, const TileRegs& r, int tid) {
    const int p0 = tid, p1 = tid + 512;
    *(LAS u32x4*)(Kt + (p0 >> 4) * KSTR + (p0 & 15) * 16) = r.k0; *(LAS u32x4*)(Kt + (p1 >> 4) * KSTR + (p1 & 15) * 16) = r.k1;
    *(LAS u32x4*)(Vt + (p0 >> 4) * KSTR + (p0 & 15) * 16) = r.v0; *(LAS u32x4*)(Vt + (p1 >> 4) * KSTR + (p1 & 15) * 16) = r.v1;
}
__device__ __forceinline__ void attn_step(ldsp Kt, ldsp Vt, const bf16x8 (&qf)[8], float& mrow, float& lrow, f32x16 (&Oc)[4], int kp0, int t, int lo, bool en, int ql, int h5, int lane) {
    if (__builtin_amdgcn_ballot_w64(en) == 0ull) return;
    f32x16 s[2];
#pragma unroll
    for (int kb = 0; kb < 2; ++kb) { s[kb] = (f32x16){};
#pragma unroll
        for (int ks = 0; ks < 8; ++ks) { const bf16x8 a = *(const LAS bf16x8*)(Kt + (32 * kb + ql) * KSTR + (16 * ks + 8 * h5) * 2); s[kb] = mfma32(a, qf[ks], s[kb]); }
        __builtin_amdgcn_sched_barrier(0); }
    float mx = -1e30f;
    const int hiL = t - kp0 - 4 * h5, loL = lo - kp0 - 4 * h5;
#pragma unroll
    for (int kb = 0; kb < 2; ++kb)
#pragma unroll
        for (int r = 0; r < 16; ++r) { const int cr = 32 * kb + (r & 3) + 8 * (r >> 2); const bool v = en && cr <= hiL && cr > loL; s[kb][r] = v ? s[kb][r] : -1e30f; mx = fmaxf(mx, s[kb][r]); }
    mx = fmaxf(mx, __shfl_xor(mx, 32));
    const float mnew = fmaxf(mrow, mx), al = ex2(mrow - mnew); mrow = mnew;
    float ps = 0.f;
#pragma unroll
    for (int kb = 0; kb < 2; ++kb)
#pragma unroll
        for (int r = 0; r < 16; ++r) { const float p = s[kb][r] > -1e29f ? ex2(s[kb][r] - mnew) : 0.f; s[kb][r] = p; ps += p; }
    lrow = lrow * al + ps;
#pragma unroll
    for (int d = 0; d < 4; ++d) Oc[d] = Oc[d] * al;
    const int li = lane & 15, tq = li >> 2, tp = li & 3, gi = (lane >> 4) & 1;
#pragma unroll
    for (int kb = 0; kb < 2; ++kb)
#pragma unroll
        for (int sx = 0; sx < 2; ++sx) {
            u32x4 pw; pw.x = pk2(s[kb][8 * sx + 0], s[kb][8 * sx + 1]); pw.y = pk2(s[kb][8 * sx + 2], s[kb][8 * sx + 3]); pw.z = pk2(s[kb][8 * sx + 4], s[kb][8 * sx + 5]); pw.w = pk2(s[kb][8 * sx + 6], s[kb][8 * sx + 7]);
            const bf16x8 pf = __builtin_bit_cast(bf16x8, pw);
            const int kbase = 32 * kb + 16 * sx + 4 * h5;
#pragma unroll
            for (int d = 0; d < 4; ++d) { const int cb = 32 * d + 16 * gi + 4 * tp;
                const s16x4 lo4 = trrd(Vt + (kbase + tq) * KSTR + cb * 2), hi4 = trrd(Vt + (kbase + 8 + tq) * KSTR + cb * 2);
                Oc[d] = mfma32(cat8(lo4, hi4), pf, Oc[d]); }
            __builtin_amdgcn_sched_barrier(0);
        }
}

__device__ __forceinline__ void nsa_phase(ldsp lds, const bf16_t* Qn, const bf16_t* KV, const bf16_t* Kc, const bf16_t* Vc, bf16_t* O) {
    const int tid = opaque_tid(), lane = tid & 63, w = rfl(tid >> 6), ql = lane & 31, h5 = lane >> 5;
    ldsp Kt = lds, Vt = lds + 128 * KSTR; LAS float* PS = (LAS float*)(lds + 256 * KSTR); LAS unsigned* SEL = (LAS unsigned*)(lds + 256 * KSTR + 32768); LAS unsigned* UNI = SEL + 64;
    const int G = gridDim.x, vcu = vcu_of();
    const int hh = w >> 1, th = w & 1, tqi = 32 * th + ql;
    for (int uu = vcu; uu < 1024; uu += G) {
        const int v8 = uu % 256, rnd = uu / 256; const int bg = v8 >> 3, s8 = v8 & 7; const int qb = rnd == 0 ? s8 : rnd == 1 ? 15 - s8 : rnd == 2 ? 16 + s8 : 31 - s8;
        const int b = bg >> 2, g = bg & 3;
        const int t = 64 * qb + tqi; const size_t row = (size_t)b * T + t;
        const bf16_t* qp = Qn + row * NQC + (4 * g + hh) * 128;
        bf16x8 qf[8];
#pragma unroll
        for (int ks = 0; ks < 8; ++ks) qf[ks] = *(const bf16x8*)(qp + 16 * ks + 8 * h5);
        float gate[3];
#pragma unroll
        for (int i = 0; i < 3; ++i) gate[i] = sigmf(bf2f(Qn[row * NQC + 2048 + (4 * g + hh) * 3 + i]));
        unsigned Oa[4][8];
        __syncthreads();
        load_tile64(Kt, Kc + (size_t)bg * 128 * 128, 128, tid); load_tile64(Kt + 64 * KSTR, Kc + (size_t)bg * 128 * 128 + 64 * 128, 128, tid);
        load_tile64(Vt, Vc + (size_t)bg * 128 * 128, 128, tid); load_tile64(Vt + 64 * KSTR, Vc + (size_t)bg * 128 * 128 + 64 * 128, 128, tid);
        if (tid == 0) UNI[0] = 0u;
        __syncthreads();
        {
            f32x16 s[4]; float mx = -1e30f;
            const int nlim = min(126, (t - 31) >> 4) - 4 * h5;
#pragma unroll
            for (int kb = 0; kb < 4; ++kb) { s[kb] = (f32x16){};
#pragma unroll
                for (int ks = 0; ks < 8; ++ks) { const bf16x8 a = *(const LAS bf16x8*)(Kt + (32 * kb + ql) * KSTR + (16 * ks + 8 * h5) * 2); s[kb] = mfma32(a, qf[ks], s[kb]); }
#pragma unroll
                for (int r = 0; r < 16; ++r) { const int cn = 32 * kb + (r & 3) + 8 * (r >> 2); const bool v = cn <= nlim; s[kb][r] = v ? s[kb][r] : -1e30f; mx = fmaxf(mx, s[kb][r]); } }
            mx = fmaxf(mx, __shfl_xor(mx, 32));
            float ps = 0.f;
#pragma unroll
            for (int kb = 0; kb < 4; ++kb)
#pragma unroll
                for (int r = 0; r < 16; ++r) { const float p = s[kb][r] > -1e29f ? ex2(s[kb][r] - mx) : 0.f; s[kb][r] = p; ps += p; }
            ps += __shfl_xor(ps, 32);
            const float inv = ps > 0.f ? 1.f / ps : 0.f;
            float Gs[16], Es[16];
#pragma unroll
            for (int kb = 0; kb < 4; ++kb)
#pragma unroll
                for (int rr = 0; rr < 4; ++rr) { float a0 = s[kb][4 * rr] * inv, a1 = s[kb][4 * rr + 1] * inv, a2 = s[kb][4 * rr + 2] * inv, a3 = s[kb][4 * rr + 3] * inv;
                    s[kb][4 * rr] = a0; s[kb][4 * rr + 1] = a1; s[kb][4 * rr + 2] = a2; s[kb][4 * rr + 3] = a3; Gs[kb * 4 + rr] = (a0 + a1) + (a2 + a3); Es[kb * 4 + rr] = a3; }
            float prevE = 0.f;
#pragma unroll
            for (int idx = 0; idx < 16; ++idx) { const float ep = __shfl_xor(Es[idx], 32); const float val = Gs[idx] + (h5 ? ep : prevE); prevE = ep;
                const int j = 8 * (idx >> 2) + 2 * (idx & 3) + h5; PS[(hh * 64 + tqi) * 32 + j] = val; }
            f32x16 Oc[4];
#pragma unroll
            for (int d = 0; d < 4; ++d) Oc[d] = (f32x16){};
            const int li = lane & 15, tq = li >> 2, tp = li & 3, gi = (lane >> 4) & 1;
#pragma unroll
            for (int kb = 0; kb < 4; ++kb)
#pragma unroll
                for (int sx = 0; sx < 2; ++sx) {
                    u32x4 pw; pw.x = pk2(s[kb][8 * sx + 0], s[kb][8 * sx + 1]); pw.y = pk2(s[kb][8 * sx + 2], s[kb][8 * sx + 3]); pw.z = pk2(s[kb][8 * sx + 4], s[kb][8 * sx + 5]); pw.w = pk2(s[kb][8 * sx + 6], s[kb][8 * sx + 7]);
                    const bf16x8 pf = __builtin_bit_cast(bf16x8, pw); const int kbase = 32 * kb + 16 * sx + 4 * h5;
#pragma unroll
                    for (int d = 0; d < 4; ++d) { const int cb = 32 * d + 16 * gi + 4 * tp;
                        const s16x4 lo4 = trrd(Vt + (kbase + tq) * KSTR + cb * 2), hi4 = trrd(Vt + (kbase + 8 + tq) * KSTR + cb * 2);
                        Oc[d] = mfma32(cat8(lo4, hi4), pf, Oc[d]); }
                    __builtin_amdgcn_sched_barrier(0);
                }
#pragma unroll
            for (int d = 0; d < 4; ++d)
#pragma unroll
                for (int r = 0; r < 8; ++r) Oa[d][r] = pk2(Oc[d][2 * r] * gate[0], Oc[d][2 * r + 1] * gate[0]);
        }
        __syncthreads();
        if (tid < 64) {
            float sc[32];
#pragma unroll
            for (int j = 0; j < 32; ++j) sc[j] = (PS[(0 * 64 + tid) * 32 + j] + PS[(1 * 64 + tid) * 32 + j]) + (PS[(2 * 64 + tid) * 32 + j] + PS[(3 * 64 + tid) * 32 + j]);
            const int cur = qb; unsigned sel = 1u | (1u << cur) | (cur > 0 ? (1u << (cur - 1)) : 0u);
            const int need = 8 - __builtin_popcount(sel);
#pragma unroll
            for (int it = 0; it < 5; ++it) if (it < need) { float best = -1.f; int bj = -1;
#pragma unroll
                for (int j = 1; j < 32; ++j) { const bool ok = (j <= cur - 2) && !((sel >> j) & 1u); if (ok && sc[j] > best) { best = sc[j]; bj = j; } }
                if (bj >= 0) sel |= 1u << bj; }
            SEL[tid] = sel; atomicOr((unsigned*)UNI, sel);
        }
        __syncthreads();
        const unsigned mysel = SEL[tqi], uni = UNI[0];
        {
            float mrow = -1e30f, lrow = 0.f; f32x16 Oc[4];
#pragma unroll
            for (int d = 0; d < 4; ++d) Oc[d] = (f32x16){};
            const bf16_t* kvb = KV + (size_t)b * T * KVC + g * 128;
            unsigned rem = uni & (0xffffffffu >> (31 - qb));
            int j = __builtin_ctz(rem); rem &= rem - 1u;
            TileRegs tr; tile_gload(tr, kvb + (size_t)(64 * j) * KVC + 2 * 512, kvb + (size_t)(64 * j) * KVC + 3 * 512, KVC, tid);
            for (;;) {
                __syncthreads();
                tile_lstore(Kt, Vt, tr, tid);
                __syncthreads();
                int jn = -1;
                if (rem) { jn = __builtin_ctz(rem); rem &= rem - 1u; tile_gload(tr, kvb + (size_t)(64 * jn) * KVC + 2 * 512, kvb + (size_t)(64 * jn) * KVC + 3 * 512, KVC, tid); }
                attn_step(Kt, Vt, qf, mrow, lrow, Oc, 64 * j, t, -1, ((mysel >> j) & 1u) != 0u, ql, h5, lane);
                if (jn < 0) break;
                j = jn;
            }
            lrow += __shfl_xor(lrow, 32); const float sc = gate[1] / lrow;
#pragma unroll
            for (int d = 0; d < 4; ++d)
#pragma unroll
                for (int r = 0; r < 8; ++r) Oa[d][r] = pk2(bflo(Oa[d][r]) + Oc[d][2 * r] * sc, bfhi(Oa[d][r]) + Oc[d][2 * r + 1] * sc);
        }
        {
            float mrow = -1e30f, lrow = 0.f; f32x16 Oc[4];
#pragma unroll
            for (int d = 0; d < 4; ++d) Oc[d] = (f32x16){};
            const bf16_t* kvb = KV + (size_t)b * T * KVC + g * 128;
            int j = (qb > 8 ? qb - 8 : 0);
            TileRegs tr; tile_gload(tr, kvb + (size_t)(64 * j) * KVC + 4 * 512, kvb + (size_t)(64 * j) * KVC + 5 * 512, KVC, tid);
            for (;;) {
                __syncthreads();
                tile_lstore(Kt, Vt, tr, tid);
                __syncthreads();
                const int jn = j + 1;
                if (jn <= qb) tile_gload(tr, kvb + (size_t)(64 * jn) * KVC + 4 * 512, kvb + (size_t)(64 * jn) * KVC + 5 * 512, KVC, tid);
                attn_step(Kt, Vt, qf, mrow, lrow, Oc, 64 * j, t, t - 512, true, ql, h5, lane);
                if (jn > qb) break;
                j = jn;
            }
            lrow += __shfl_xor(lrow, 32); const float sc = gate[2] / lrow;
            bf16_t* op = O + row * D + (4 * g + hh) * 128 + 4 * h5;
#pragma unroll
            for (int d = 0; d < 4; ++d)
#pragma unroll
                for (int rr = 0; rr < 4; ++rr) { u32x2 wv;
                    wv.x = pk2(bflo(Oa[d][2 * rr]) + Oc[d][4 * rr] * sc, bfhi(Oa[d][2 * rr]) + Oc[d][4 * rr + 1] * sc);
                    wv.y = pk2(bflo(Oa[d][2 * rr + 1]) + Oc[d][4 * rr + 2] * sc, bfhi(Oa[d][2 * rr + 1]) + Oc[d][4 * rr + 3] * sc);
                    *(u32x2*)(op + 32 * d + 8 * rr) = wv; }
        }
    }
    __syncthreads();
}

#define XB_TMO      128
#define XB_XCNT(j)  (256  + 64 * (j))
#define XB_XSUB(j)  (1280 + 64 * (j))
#define XB_XGEN(j)  (2304 + 64 * (j))
#define XB_TOP      3328
#define XB_TOPGEN   3392
#define XCD_BAR_WORDS 3456
#define XB_SPIN_CAP (1u << 18)
__device__ __forceinline__ unsigned xb_ld(unsigned* p)              { return __hip_atomic_load(p, __ATOMIC_RELAXED, __HIP_MEMORY_SCOPE_AGENT); }
__device__ __forceinline__ unsigned xb_add(unsigned* p, unsigned v) { return __hip_atomic_fetch_add(p, v, __ATOMIC_RELAXED, __HIP_MEMORY_SCOPE_AGENT); }
__device__ __forceinline__ unsigned xb_xcc_id() { return (unsigned)__builtin_amdgcn_s_getreg((3 << 11) | 20) & 0xFu; }
#define XB_SPIN(cond, bar) do { unsigned _sp = 0; while (cond) { __builtin_amdgcn_s_sleep(1); \
    if ((++_sp & 255u) == 0u) { if (xb_ld(&(bar)[XB_TMO])) break; if (_sp > XB_SPIN_CAP) { atomicAdd(&(bar)[XB_TMO], 1u); break; } } } } while (0)
struct XcdBarrier { unsigned* bar; unsigned x; volatile LAS unsigned* st; };
__device__ __forceinline__ XcdBarrier xcd_barrier_post(unsigned* bar, volatile LAS unsigned* st) {
    XcdBarrier b; b.bar = bar; b.x = xb_xcc_id(); b.st = st;
    if (threadIdx.x == 0) (void)xb_add(&bar[XB_XCNT(b.x)], 1u);
    return b;
}
__device__ __forceinline__ void xcd_barrier_complete(unsigned* bar, unsigned x, unsigned& nloc, unsigned& nx) {
    const unsigned G = gridDim.x * gridDim.y * gridDim.z;
    unsigned sum, cnt, mine, sp = 0u;
    for (;;) {
        sum = 0u; cnt = 0u; mine = 0u;
#pragma unroll
        for (unsigned j = 0; j < 16; ++j) { const unsigned c = xb_ld(&bar[XB_XCNT(j)]); sum += c; cnt += (c > 0u) ? 1u : 0u; mine = (j == x) ? c : mine; }
        if (sum == G) break;
        __builtin_amdgcn_s_sleep(1);
        if ((++sp & 255u) == 0u) { if (xb_ld(&bar[XB_TMO])) break; if (sp > XB_SPIN_CAP) { atomicAdd(&bar[XB_TMO], 1u); break; } }
    }
    nloc = mine > 0u ? mine : 1u; nx = cnt > 0u ? cnt : 1u;
}
__device__ __forceinline__ void xcd_barrier(const XcdBarrier& b) {
    asm volatile("s_waitcnt vmcnt(0)" ::: "memory");
    __syncthreads();
    if (threadIdx.x == 0) {
        unsigned* bar = b.bar;
        __builtin_amdgcn_s_waitcnt(0);
        unsigned nloc = b.st[0], nx = b.st[1];
        if (nloc == 0u) { xcd_barrier_complete(bar, b.x, nloc, nx); b.st[0] = nloc; b.st[1] = nx; }
        const unsigned old = xb_add(&bar[XB_XSUB(b.x)], 1u);
        const unsigned gen = old / nloc;
        if (old + 1u == (gen + 1u) * nloc) {
            __builtin_amdgcn_fence(__ATOMIC_RELEASE, "agent");
            asm volatile("s_waitcnt vmcnt(0)" ::: "memory");
            const unsigned og = xb_add(&bar[XB_TOP], 1u);
            const unsigned tg = og / nx;
            if (og + 1u == (tg + 1u) * nx) xb_add(&bar[XB_TOPGEN], 1u);
            else XB_SPIN(xb_ld(&bar[XB_TOPGEN]) == tg, bar);
            __builtin_amdgcn_fence(__ATOMIC_ACQUIRE, "agent");
            xb_add(&bar[XB_XGEN(b.x)], 1u);
            asm volatile("s_waitcnt vmcnt(0)" ::: "memory");
        } else {
            XB_SPIN(xb_ld(&bar[XB_XGEN(b.x)]) == gen, bar);
            __builtin_amdgcn_fence(__ATOMIC_ACQUIRE, "agent");
            asm volatile("s_waitcnt vmcnt(0)" ::: "memory");
        }
    }
    __syncthreads();
}

#ifndef COSF
#define COSF cosf
#define SINF sinf
#endif
#ifndef GMASK
#define GMASK 0xffff
#endif
constexpr int NPHASE = 26;
typedef const __attribute__((address_space(4))) Params* cparams_t;
__device__ __forceinline__ cparams_t kparams() { const __attribute__((address_space(4))) void* q = (const __attribute__((address_space(4))) void*)__builtin_amdgcn_kernarg_segment_ptr(); asm volatile("" : "+s"(q)); return (cparams_t)q; }
#define PHASE_BEGIN if (lo <= ph && ph < hi) { cparams_t pp = kparams(); unsigned char* ws = pp->ws; bf16_t* Xb = (bf16_t*)(ws + WS_XB); bf16_t* KVb = (bf16_t*)(ws + WS_KV); bf16_t* R = (bf16_t*)(ws + WS_R); bf16_t* Hb = (bf16_t*)(ws + WS_R + R_H); \
    float* rcos = (float*)(ws + WS_ROPE_R); float* rsin = rcos + 2048 * 128; float* ncos = (float*)(ws + WS_ROPE_N); float* nsin = ncos + 2048 * 16; (void)Xb; (void)KVb; (void)R; (void)Hb; (void)rcos; (void)rsin; (void)ncos; (void)nsin;
#define PHASE_END } if (lo <= ph && ph + 1 < hi) xcd_barrier(bar); ++ph;

template <int layer> __device__ __forceinline__ void run_layer(ldsp lds, const XcdBarrier& bar, const int lo, const int hi, int& ph, const int G) {
        PHASE_BEGIN
            pg8::Gemm g{Xb, (const bf16_t*)(ws + W_FFN1_IN), M, 2 * FF, D, D}; pg8::StaticOrder S; S.init(M, 2 * FF, G, (int)blockIdx.x);
            pg8::Epi<pg8::EPI_SWIGLU> E{Hb, nullptr, FF, 0.f, 0.f, nullptr, nullptr};
            if (GMASK & (1 << 0)) pg8::gemm_phase(lds, g, S, E);
        PHASE_END
        PHASE_BEGIN
            pg8::Gemm g{Hb, (const bf16_t*)(ws + W_FFN1_OUT), M, D, FF, FF}; pg8::LnOrder S{vcu_of()};
            pg8::EpiLN E{pp->out, layer == 0 ? pp->x : pp->out, Xb, pp->ln_g + (layer * 3 + 0) * D, pp->ln_b + (layer * 3 + 0) * D, ALPHA, 0.5f, (unsigned long long*)(ws + WS_XBUF), (unsigned*)(ws + WS_CNT) + (layer * 3 + 0) * 4096, lds + 131072, G == 256 ? 1 : 0};
            pg8::gemm_phase(lds, g, S, E);
        PHASE_END
        if constexpr (layer == 0) {
            PHASE_BEGIN
                pg8::Gemm g{Xb, (const bf16_t*)(ws + W_RET_IN), M, RETC, D, D}; pg8::StaticOrder S; S.init(M, RETC, G, (int)blockIdx.x);
                pg8::Epi<pg8::EPI_RET> E{R, nullptr, RETC, 0.f, 0.f, rcos, rsin};
                if (GMASK & (1 << 2)) pg8::gemm_phase(lds, g, S, E);
            PHASE_END
            PHASE_BEGIN
#ifndef SKIP_RET
                ret_phase(lds, R);
#endif
            PHASE_END
            PHASE_BEGIN
                gn_phase(R, pp->gn_g, pp->gn_b);
            PHASE_END
            PHASE_BEGIN
                pg8::Gemm g{R + 8192, (const bf16_t*)(ws + W_RET_OUT), M, D, 4096, RETC}; pg8::LnOrder S{vcu_of()};
            pg8::EpiLN E{pp->out, pp->out, Xb, pp->ln_g + (layer * 3 + 1) * D, pp->ln_b + (layer * 3 + 1) * D, ALPHA, 1.0f, (unsigned long long*)(ws + WS_XBUF), (unsigned*)(ws + WS_CNT) + (layer * 3 + 1) * 4096, lds + 131072, G == 256 ? 1 : 0};
            pg8::gemm_phase(lds, g, S, E);
            PHASE_END
        } else {
            PHASE_BEGIN
                pg8::Gemm g{Xb, (const bf16_t*)(ws + W_NSA_Q), M, NQC, D, D}; pg8::StaticOrder S; S.init(M, NQC, G, (int)blockIdx.x);
                pg8::Epi<pg8::EPI_NSAQ> E{(bf16_t*)(ws + WS_R + R_QN), nullptr, NQC, QSCALE, 0.f, ncos, nsin};
                if (GMASK & (1 << 4)) pg8::gemm_phase(lds, g, S, E);
            PHASE_END
            PHASE_BEGIN
#ifndef SKIP_NSA
                nsa_phase(lds, (const bf16_t*)(ws + WS_R + R_QN), KVb, (const bf16_t*)(ws + WS_KC), (const bf16_t*)(ws + WS_VC), (bf16_t*)(ws + WS_R + R_O));
#endif
            PHASE_END
            PHASE_BEGIN
                pg8::Gemm g{(const bf16_t*)(ws + WS_R + R_O), (const bf16_t*)(ws + W_NSA_OUT), M, D, D, D}; pg8::LnOrder S{vcu_of()};
            pg8::EpiLN E{pp->out, pp->out, Xb, pp->ln_g + (layer * 3 + 1) * D, pp->ln_b + (layer * 3 + 1) * D, ALPHA, 1.0f, (unsigned long long*)(ws + WS_XBUF), (unsigned*)(ws + WS_CNT) + (layer * 3 + 1) * 4096, lds + 131072, G == 256 ? 1 : 0};
            pg8::gemm_phase(lds, g, S, E);
            PHASE_END
        }
        PHASE_BEGIN
            pg8::Gemm g{Xb, (const bf16_t*)(ws + W_FFN2_IN), M, 2 * FF, D, D}; pg8::StaticOrder S; S.init(M, 2 * FF, G, (int)blockIdx.x);
            pg8::Epi<pg8::EPI_SWIGLU> E{Hb, nullptr, FF, 0.f, 0.f, nullptr, nullptr};
            if (GMASK & (1 << 6)) pg8::gemm_phase(lds, g, S, E);
        PHASE_END
        PHASE_BEGIN
            pg8::Gemm g{Hb, (const bf16_t*)(ws + W_FFN2_OUT), M, D, FF, FF}; pg8::LnOrder S{vcu_of()};
            pg8::EpiLN E{pp->out, pp->out, Xb, pp->ln_g + (layer * 3 + 2) * D, pp->ln_b + (layer * 3 + 2) * D, ALPHA, 0.5f, (unsigned long long*)(ws + WS_XBUF), (unsigned*)(ws + WS_CNT) + (layer * 3 + 2) * 4096, lds + 131072, G == 256 ? 1 : 0};
            pg8::gemm_phase(lds, g, S, E);
        PHASE_END
        if constexpr (layer == 0) {
            PHASE_BEGIN
                pg8::Gemm g{Xb, (const bf16_t*)(ws + W_KV), M, KVC, D, D}; pg8::StaticOrder S; S.init(M, KVC, G, (int)blockIdx.x);
                pg8::Epi<pg8::EPI_KV> E{KVb, nullptr, KVC, 1.f, 0.f, ncos, nsin};
                if (GMASK & (1 << 8)) pg8::gemm_phase(lds, g, S, E);
            PHASE_END
            PHASE_BEGIN
                cmp_gather_phase(KVb, pp->cmp_pos, (bf16_t*)(ws + WS_R + R_ACMP));
            PHASE_END
            PHASE_BEGIN
                if (blockIdx.x < 64) {
                pg8::Gemm g{(const bf16_t*)(ws + WS_R + R_ACMP), (const bf16_t*)(ws + W_CMP1), 8192, 1024, 4096, 4096}; pg8::CmpOrder S{G, (int)blockIdx.x};
                pg8::Epi<pg8::EPI_CMP1> E{(bf16_t*)(ws + WS_R + R_HC), pp->cmp_b1, 512, 0.f, 0.f, nullptr, nullptr};
                pg8::gemm_phase(lds, g, S, E);
                } else {
                const int gw = ((int)blockIdx.x - 64) * 8 + rfl((int)threadIdx.x >> 6), NGW = (G - 64) * 8;
                convert_part(lds, pp->ffn1_in + (size_t)D * 2 * FF, D, 2 * FF, 2 * FF, 1, (bf16_t*)(ws + W_FFN1_IN), gw, NGW);
                convert_part(lds, pp->ffn1_out + (size_t)FF * D, FF, D, D, 0, (bf16_t*)(ws + W_FFN1_OUT), gw, NGW);
                convert_part(lds, pp->ffn2_in + (size_t)D * 2 * FF, D, 2 * FF, 2 * FF, 1, (bf16_t*)(ws + W_FFN2_IN), gw, NGW);
                convert_part(lds, pp->ffn2_out + (size_t)FF * D, FF, D, D, 0, (bf16_t*)(ws + W_FFN2_OUT), gw, NGW);
                convert_part(lds, pp->nsa_q, D, 2096, NQC, 0, (bf16_t*)(ws + W_NSA_Q), gw, NGW);
                convert_part(lds, pp->nsa_out, D, D, D, 0, (bf16_t*)(ws + W_NSA_OUT), gw, NGW);
                }
            PHASE_END
            PHASE_BEGIN
                cmp2_phase((const bf16_t*)(ws + WS_R + R_HC), pp->cmp_w2, ncos, nsin, (bf16_t*)(ws + WS_KC), (bf16_t*)(ws + WS_VC));
            PHASE_END
        }
    }

__global__ void __launch_bounds__(512, 2) yoco_fwd(Params p) {
    extern __shared__ __attribute__((aligned(16))) unsigned char lds_raw[];
    ldsp lds = (ldsp)lds_raw;
    cg::grid_group grid = cg::this_grid();
    if (threadIdx.x < 2) ((volatile LAS unsigned*)(lds + 131072 + 10240 + 64))[threadIdx.x] = 0u;
    __syncthreads();
    const int G = gridDim.x;
    const int lo = p.ph_lo, hi = p.ph_hi;
    int ph = 0;
    {   cparams_t pp = kparams(); unsigned char* ws = pp->ws; bf16_t* Xb = (bf16_t*)(ws + WS_XB);
        float* rcos = (float*)(ws + WS_ROPE_R); float* rsin = rcos + 2048 * 128; float* ncos = (float*)(ws + WS_ROPE_N); float* nsin = ncos + 2048 * 16;
        convert_one(lds, pp->ffn1_in, D, 2 * FF, 2 * FF, 1, (bf16_t*)(ws + W_FFN1_IN));
        convert_one(lds, pp->ffn1_out, FF, D, D, 0, (bf16_t*)(ws + W_FFN1_OUT));
        convert_one(lds, pp->ffn2_in, D, 2 * FF, 2 * FF, 1, (bf16_t*)(ws + W_FFN2_IN));
        convert_one(lds, pp->ffn2_out, FF, D, D, 0, (bf16_t*)(ws + W_FFN2_OUT));
        convert_one(lds, pp->ret_in, D, RETC, RETC, 0, (bf16_t*)(ws + W_RET_IN));
        convert_one(lds, pp->ret_out, 4096, D, D, 0, (bf16_t*)(ws + W_RET_OUT));
        convert_one(lds, pp->kv_w, D, KVC, KVC, 0, (bf16_t*)(ws + W_KV));
        convert_one(lds, pp->cmp_w1, 4096, 512, 512, 0, (bf16_t*)(ws + W_CMP1));
        convert_one(lds, pp->cmp_w1 + (size_t)4096 * 512, 4096, 512, 512, 0, (bf16_t*)(ws + W_CMP1) + (size_t)512 * 4096);
        const size_t gt = (size_t)blockIdx.x * 512 + threadIdx.x, NT = (size_t)G * 512;
        for (size_t i = gt; i < (size_t)6 * 4096; i += NT) ((unsigned*)(ws + WS_CNT))[i] = 0u;
        for (size_t i = gt; i < (size_t)XCD_BAR_WORDS; i += NT) ((unsigned*)(ws + WS_BAR))[i] = 0u;
        for (size_t i = gt; i < (size_t)2048 * 128; i += NT) { const int pos = (int)(i >> 7), f = (int)(i & 127); const float inv = powf(10000.f, -(float)f / 128.f); const float ang = (float)pos * inv; rcos[i] = COSF(ang); rsin[i] = SINF(ang); }
        for (size_t i = gt; i < (size_t)2048 * 16; i += NT) { const int pos = (int)(i >> 4), f = (int)(i & 15); const float inv = powf(500000.f, -(float)f / 16.f); const float ang = (float)pos * inv; ncos[i] = COSF(ang); nsin[i] = SINF(ang); }
        for (size_t i = gt; i < (size_t)M * D / 8; i += NT) { const f32x4 a = *(const f32x4*)(pp->x + i * 8), b2 = *(const f32x4*)(pp->x + i * 8 + 4); u32x4 w; w.x = pk2(a[0], a[1]); w.y = pk2(a[2], a[3]); w.z = pk2(b2[0], b2[1]); w.w = pk2(b2[2], b2[3]); *(u32x4*)(Xb + i * 8) = w; }
    }
    grid.sync();
    ++ph;
    const XcdBarrier bar = xcd_barrier_post((unsigned*)(kparams()->ws + WS_BAR), (volatile LAS unsigned*)(lds + 131072 + 10240 + 64));

    run_layer<0>(lds, bar, lo, hi, ph, G);
    run_layer<1>(lds, bar, lo, hi, ph, G);
#undef PHASE_BEGIN
#undef PHASE_END
}

#ifndef N_LAUNCH_MODE
#define N_LAUNCH_MODE 1
#endif
extern "C" void kernel_launch(void* const* d_in, const int* in_sizes, int n_in, void* d_out, int out_size, void* d_ws, size_t ws_size, hipStream_t stream) {
    static int inited = 0;
    if (!inited) { (void)hipFuncSetAttribute((const void*)yoco_fwd, hipFuncAttributeMaxDynamicSharedMemorySize, LDS_BYTES); inited = 1; }
    Params p{};
    p.x = (const float*)d_in[0]; p.ln_g = (const float*)d_in[1]; p.ln_b = (const float*)d_in[2];
    p.ffn1_in = (const float*)d_in[3]; p.ffn1_out = (const float*)d_in[4]; p.ffn2_in = (const float*)d_in[5]; p.ffn2_out = (const float*)d_in[6];
    p.ret_in = (const float*)d_in[7]; p.gn_g = (const float*)d_in[8]; p.gn_b = (const float*)d_in[9]; p.ret_out = (const float*)d_in[10];
    p.kv_w = (const float*)d_in[11]; p.cmp_pos = (const float*)d_in[12]; p.cmp_w1 = (const float*)d_in[13]; p.cmp_b1 = (const float*)d_in[14]; p.cmp_w2 = (const float*)d_in[15];
    p.nsa_q = (const float*)d_in[16]; p.nsa_out = (const float*)d_in[17];
    p.out = (float*)d_out; p.ws = (unsigned char*)d_ws;
    p.ph_lo = 0; p.ph_hi = 64;
    void* args[] = {&p};
    hipError_t e = hipLaunchCooperativeKernel((const void*)yoco_fwd, dim3(256), dim3(512), args, LDS_BYTES, stream);
    if (e != hipSuccess) fprintf(stderr, "cooperative launch failed: %s\n", hipGetErrorString(e));
}
```
